# Optimizing an MI355X kernel written in HIP

```python
import math
import jax, jax.numpy as jnp
from jax import lax
import numpy as np

D_MODEL = 2048
BATCH = 2
SEQ = 8192
DEPTH = 1

GRID_W = 64
CTX_LEN = 256

DA_HEADS = 8
DA_HEAD_DIM = 64
DA_V = 2 * DA_HEAD_DIM
MLA_HEADS = 8
MLA_Q_RANK = 512
MLA_KV_RANK = 256
MLA_NOPE = 128
MLA_ROPE = 64
MLA_V = 128
MLA_SCALE = (MLA_NOPE + MLA_ROPE) ** -0.5
ROPE_DIM = 64
ROPE_THETA = 10000.0
FFN_HIDDEN = -(-8 * D_MODEL // (3 * 256)) * 256

Q_BLOCK = 128
EPS = 1e-6

DA_Q_W = DA_HEADS * 2 * DA_HEAD_DIM
DA_K_W = DA_HEADS * 2 * DA_HEAD_DIM
DA_V_W = DA_HEADS * DA_V
_IN_SIZES = (DA_Q_W, DA_K_W, DA_V_W, MLA_Q_RANK, MLA_KV_RANK, MLA_ROPE, D_MODEL, D_MODEL)
_IN_SPLITS = tuple(sum(_IN_SIZES[:i + 1]) for i in range(len(_IN_SIZES) - 1))
IN_W = sum(_IN_SIZES)

kernel_name = "hybrid_diffattn_mla_gated_dit_block"


def _rmsnorm(x, g):
    xf = x.astype(jnp.float32)
    y = xf * lax.rsqrt(jnp.mean(xf * xf, axis=-1, keepdims=True) + EPS)
    return (y * g.astype(jnp.float32)).astype(x.dtype)


def _modulate(h, shift, scale):
    return h * (1 + scale) + shift


def _swiglu(h, w_gate, w_up, w_down):
    return (jax.nn.silu(h @ w_gate) * (h @ w_up)) @ w_down


def _rope_tables(n):
    t = jnp.arange(n, dtype=jnp.int32)
    row = (t // GRID_W).astype(jnp.float32)
    col = (t % GRID_W).astype(jnp.float32)
    nf = ROPE_DIM // 4
    inv = ROPE_THETA ** (-jnp.arange(nf, dtype=jnp.float32) / nf)
    ar = row[:, None] * inv
    ac = col[:, None] * inv
    return (jnp.cos(ar), jnp.sin(ar), jnp.cos(ac), jnp.sin(ac))


def _rope_half(x, cos, sin):
    x1, x2 = jnp.split(x.astype(jnp.float32), 2, axis=-1)
    c = cos[None, :, None, :]
    s = sin[None, :, None, :]
    return jnp.concatenate([x1 * c - x2 * s, x2 * c + x1 * s], axis=-1)


def _axial_rope(x, tabs):
    cr, sr, cc, sc = tabs
    xr, xc = jnp.split(x, 2, axis=-1)
    return jnp.concatenate([_rope_half(xr, cr, sr), _rope_half(xc, cc, sc)], axis=-1).astype(x.dtype)


def _sweep_queries(q, block_fn):
    b, n, h, d = q.shape
    nb = n // Q_BLOCK
    qb = q.reshape(b, nb, Q_BLOCK, h, d).transpose(1, 0, 2, 3, 4)
    out = lax.map(block_fn, qb)
    return out.transpose(1, 0, 2, 3, 4).reshape(b, n, out.shape[3], out.shape[4])


def _diff_attend(q, k, v, lam):
    s = jnp.einsum("bqhd,bkhd->bhqk", q, k, preferred_element_type=jnp.float32) * (DA_HEAD_DIM ** -0.5)
    p = jax.nn.softmax(s, axis=-1)
    b, hh, nq, nk = p.shape
    p = p.reshape(b, hh // 2, 2, nq, nk)
    a = p[:, :, 0] - lam * p[:, :, 1]
    return jnp.einsum("bhqk,bkhd->bqhd", a.astype(v.dtype), v)


def _softmax_attend(q, k, v, scale):
    s = jnp.einsum("bqhd,bkhd->bhqk", q, k, preferred_element_type=jnp.float32) * scale
    p = jax.nn.softmax(s, axis=-1)
    return jnp.einsum("bhqk,bkhd->bqhd", p.astype(v.dtype), v)


def _project(h, w_in, mla_q_g, mla_kv_g, w_uq, w_ukv, tabs):
    b, n, _ = h.shape
    z = h @ w_in
    dq, dk, dv, cq, ckv, kr, ga, gb = jnp.split(z, _IN_SPLITS, axis=-1)
    dq = dq.reshape(b, n, 2 * DA_HEADS, DA_HEAD_DIM)
    dk = dk.reshape(b, n, 2 * DA_HEADS, DA_HEAD_DIM)
    dv = dv.reshape(b, n, DA_HEADS, DA_V)
    q = (_rmsnorm(cq, mla_q_g) @ w_uq).reshape(b, n, MLA_HEADS, MLA_NOPE + MLA_ROPE)
    kv = (_rmsnorm(ckv, mla_kv_g) @ w_ukv).reshape(b, n, MLA_HEADS, MLA_NOPE + MLA_V)
    q_nope, q_rope = jnp.split(q, [MLA_NOPE], axis=-1)
    k_nope, mv = jnp.split(kv, [MLA_NOPE], axis=-1)
    k_rope = kr[:, :, None, :]
    if tabs is not None:
        dq = _axial_rope(dq, tabs)
        dk = _axial_rope(dk, tabs)
        q_rope = _axial_rope(q_rope, tabs)
        k_rope = _axial_rope(k_rope, tabs)
    mq = jnp.concatenate([q_nope, q_rope], axis=-1)
    mk = jnp.concatenate([k_nope, jnp.broadcast_to(k_rope, (b, n, MLA_HEADS, MLA_ROPE))], axis=-1)
    return dq, dk, dv, mq, mk, mv, ga, gb


def _merge(o_da, o_mla, ga, gb, da_g, lam_init, w_o_da, w_o_mla, w_out):
    b, n = o_da.shape[:2]
    o_da = _rmsnorm(o_da, da_g) * (1.0 - lam_init)
    y_a = o_da.reshape(b, n, DA_HEADS * DA_V) @ w_o_da
    y_b = o_mla.reshape(b, n, MLA_HEADS * MLA_V) @ w_o_mla
    return (jax.nn.sigmoid(ga) * y_a + jax.nn.sigmoid(gb) * y_b) @ w_out


def setup_inputs(seed: int = 0) -> dict:
    key = jax.random.key(seed)
    ks = jax.random.split(key, 22)
    f32 = jnp.float32

    def w(k, shape, fan_in):
        return jax.random.normal(k, shape, f32) * fan_in ** -0.5

    def gain(k, shape):
        return 1.0 + 0.02 * jax.random.normal(k, shape, f32)

    return {
        "x": jax.random.normal(ks[0], (BATCH, SEQ, D_MODEL), f32),
        "c": jax.random.normal(ks[1], (BATCH, D_MODEL), f32),
        "ctx": jax.random.normal(ks[2], (BATCH, CTX_LEN, D_MODEL), f32),
        "c_ctx": jax.random.normal(ks[3], (D_MODEL,), f32),
        "w_ada": w(ks[4], (DEPTH, D_MODEL, 6 * D_MODEL), D_MODEL),
        "b_ada": 0.01 * jax.random.normal(ks[5], (DEPTH, 6 * D_MODEL), f32),
        "norm1_g": gain(ks[6], (DEPTH, D_MODEL)),
        "norm2_g": gain(ks[7], (DEPTH, D_MODEL)),
        "w_in": w(ks[8], (DEPTH, D_MODEL, IN_W), D_MODEL),
        "da_lambda": 0.1 * jax.random.normal(ks[9], (DEPTH, 4, DA_HEAD_DIM), f32),
        "da_subln_g": gain(ks[10], (DEPTH, DA_V)),
        "mla_q_norm_g": gain(ks[11], (DEPTH, MLA_Q_RANK)),
        "mla_kv_norm_g": gain(ks[12], (DEPTH, MLA_KV_RANK)),
        "w_uq": w(ks[13], (DEPTH, MLA_Q_RANK, MLA_HEADS * (MLA_NOPE + MLA_ROPE)), MLA_Q_RANK),
        "w_ukv": w(ks[14], (DEPTH, MLA_KV_RANK, MLA_HEADS * (MLA_NOPE + MLA_V)), MLA_KV_RANK),
        "w_o_da": w(ks[15], (DEPTH, DA_HEADS * DA_V, D_MODEL), DA_HEADS * DA_V),
        "w_o_mla": w(ks[16], (DEPTH, MLA_HEADS * MLA_V, D_MODEL), MLA_HEADS * MLA_V),
        "w_out": w(ks[17], (DEPTH, D_MODEL, D_MODEL), D_MODEL),
        "w_ffn_gate": w(ks[18], (DEPTH, D_MODEL, FFN_HIDDEN), D_MODEL),
        "w_ffn_up": w(ks[19], (DEPTH, D_MODEL, FFN_HIDDEN), D_MODEL),
        "w_ffn_down": w(ks[20], (DEPTH, FFN_HIDDEN, D_MODEL), FFN_HIDDEN),
        "final_norm_g": gain(ks[21], (D_MODEL,)),
    }


def reference(x, c, ctx, c_ctx, w_ada, b_ada, norm1_g, norm2_g, w_in, da_lambda, da_subln_g,
              mla_q_norm_g, mla_kv_norm_g, w_uq, w_ukv, w_o_da, w_o_mla, w_out,
              w_ffn_gate, w_ffn_up, w_ffn_down, final_norm_g):
    n = x.shape[1]
    tabs = _rope_tables(n)
    for i in range(DEPTH):
        last = i == DEPTH - 1
        lam_init = 0.8 - 0.6 * math.exp(-0.3 * i)
        lp = da_lambda[i].astype(jnp.float32)
        lam = jnp.exp(jnp.sum(lp[0] * lp[1])) - jnp.exp(jnp.sum(lp[2] * lp[3])) + lam_init

        mod = (jax.nn.silu(c) @ w_ada[i] + b_ada[i])[:, None, :]
        mod_c = jax.nn.silu(c_ctx) @ w_ada[i] + b_ada[i]
        sh1, sc1, g1, sh2, sc2, g2 = jnp.split(mod, 6, axis=-1)
        csh1, csc1, cg1, csh2, csc2, cg2 = jnp.split(mod_c, 6, axis=-1)

        h_lat = _modulate(_rmsnorm(x, norm1_g[i]), sh1, sc1)
        h_ctx = _modulate(_rmsnorm(ctx, norm1_g[i]), csh1, csc1)
        dq, dk, dv, mq, mk, mv, ga, gb = _project(
            h_lat, w_in[i], mla_q_norm_g[i], mla_kv_norm_g[i], w_uq[i], w_ukv[i], tabs)
        cdq, cdk, cdv, cmq, cmk, cmv, cga, cgb = _project(
            h_ctx, w_in[i], mla_q_norm_g[i], mla_kv_norm_g[i], w_uq[i], w_ukv[i], None)

        dk_all = jnp.concatenate([cdk, dk], axis=1)
        dv_all = jnp.concatenate([cdv, dv], axis=1)
        mk_all = jnp.concatenate([cmk, mk], axis=1)
        mv_all = jnp.concatenate([cmv, mv], axis=1)
        o_da = _sweep_queries(dq, lambda qb: _diff_attend(qb, dk_all, dv_all, lam))
        o_mla = _sweep_queries(mq, lambda qb: _softmax_attend(qb, mk_all, mv_all, MLA_SCALE))
        x = x + g1 * _merge(o_da, o_mla, ga, gb, da_subln_g[i], lam_init, w_o_da[i], w_o_mla[i], w_out[i])
        x = x + g2 * _swiglu(_modulate(_rmsnorm(x, norm2_g[i]), sh2, sc2),
                             w_ffn_gate[i], w_ffn_up[i], w_ffn_down[i])

        if not last:
            co_da = _diff_attend(cdq, cdk, cdv, lam)
            co_mla = _softmax_attend(cmq, cmk, cmv, MLA_SCALE)
            ctx = ctx + cg1 * _merge(co_da, co_mla, cga, cgb, da_subln_g[i], lam_init,
                                     w_o_da[i], w_o_mla[i], w_out[i])
            ctx = ctx + cg2 * _swiglu(_modulate(_rmsnorm(ctx, norm2_g[i]), csh2, csc2),
                                      w_ffn_gate[i], w_ffn_up[i], w_ffn_down[i])
    return _rmsnorm(x, final_norm_g)
```

```cpp
#include <hip/hip_runtime.h>
#include <hip/hip_cooperative_groups.h>
#include <cstdio>
#include <cstdint>
namespace cg = cooperative_groups;

#define LAS __attribute__((address_space(3)))
typedef unsigned short bf16_t;
typedef short bf16x8 __attribute__((ext_vector_type(8)));
typedef short s16x4 __attribute__((ext_vector_type(4)));
typedef float f32x2 __attribute__((ext_vector_type(2)));
typedef float f32x4 __attribute__((ext_vector_type(4)));
typedef float f32x16 __attribute__((ext_vector_type(16)));
typedef unsigned u32x2 __attribute__((ext_vector_type(2)));
typedef unsigned u32x4 __attribute__((ext_vector_type(4)));

#ifndef ATT_TWO_DA
#define ATT_TWO_DA false
#endif
#ifndef ATT_TWO_MLA
#define ATT_TWO_MLA false
#endif
#ifndef MK_PER_PHASE
#define MK_PER_PHASE 0
#endif

constexpr int DM = 2048, NB = 2, SEQ = 8192, CTX = 256;
constexpr int ROWS_B = SEQ + CTX;
constexpr int MR = NB * ROWS_B;
constexpr int ML = NB * SEQ;
constexpr int ZW = 8192;
constexpr int Z_DQ = 0, Z_DK = 1024, Z_DV = 2048, Z_CQ = 3072, Z_CKV = 3584, Z_KR = 3840, Z_GA = 4096, Z_GB = 6144;
constexpr int FF = 5632, INW = 8000, MODW = 6 * DM;
constexpr int MQW = 1536, KVW = 2048, OW = 1024;
constexpr float EPS = 1e-6f;
constexpr float LOG2E = 1.4426950408889634f;
constexpr float C_DA = 0.125f * LOG2E;
constexpr float C_MLA = 0.07216878364870322f * LOG2E;
constexpr float LAM_INIT = 0.2f;

constexpr size_t MiB = 1u << 20;
constexpr size_t WS_MOD = 0;
constexpr size_t MOD_BYTES = 3 * MODW * 4;
constexpr size_t WS_BAR = 160 * 1024;
constexpr size_t WS_RSQ = 176 * 1024;
constexpr size_t WS_RSKV = 244 * 1024;
constexpr size_t CTL_ZERO_BYTES = 312 * 1024;
constexpr size_t WS_ROPE = 768 * 1024;
constexpr size_t WS_WIN = 1 * MiB;
constexpr size_t WS_WUQ = 33 * MiB;
constexpr size_t WS_WUKV = 35 * MiB;
constexpr size_t WS_WODA = 36 * MiB;
constexpr size_t WS_WOMLA = 40 * MiB;
constexpr size_t WS_WOUT = 44 * MiB;
constexpr size_t WS_WGU = 52 * MiB;
constexpr size_t WS_WD = 96 * MiB;
constexpr size_t WS_H = 118 * MiB;
constexpr size_t WS_Z = 184 * MiB;
constexpr size_t WS_MQ = 448 * MiB;
constexpr size_t WS_END = 498 * MiB;
constexpr size_t OUT_STASH = 0;
constexpr size_t OUT_OMLA = 32 * MiB;
constexpr size_t OUT_ODA = 66 * MiB;

constexpr int NWAVES = 8;
constexpr int LDS_ROPE = 131072;
constexpr int LDS_MISC = 154 * 1024;
constexpr int LDS_BYTES = 154 * 1024 + 256;

__device__ __forceinline__ unsigned cvt_pk_bf16(float lo, float hi) { unsigned r; asm volatile("v_cvt_pk_bf16_f32 %0, %1, %2" : "=v"(r) : "v"(lo), "v"(hi)); return r; }
__device__ __forceinline__ float bf_lo(unsigned w) { return __uint_as_float(w << 16); }
__device__ __forceinline__ float bf_hi(unsigned w) { return __uint_as_float(w & 0xffff0000u); }
__device__ __forceinline__ float wave_sum(float v) {
#pragma unroll
    for (int o = 1; o < 64; o <<= 1) v += __shfl_xor(v, o);
    return v;
}
__device__ __forceinline__ float sigmoidf_(float x) { return __builtin_amdgcn_rcpf(1.0f + __expf(-x)); }
__device__ __forceinline__ int r_to_l(int r) { return r - 256 * (1 + (r >= ROWS_B ? 1 : 0)); }

namespace pg8 {
constexpr int BM = 256, BK = 64, HALF = 128, HTB = HALF * BK * 2, STAGE_BYTES = 8 * HTB, NXCD = 8, WGM = 8;
__host__ __device__ __forceinline__ int lds_byte(int r, int c) { const int st = (r >> 4) * 2 + (c >> 5), rr = r & 15, cc = c & 31, ob = rr * 64 + cc * 2; return st * 1024 + (ob ^ (((ob >> 9) & 1) << 5)); }
__host__ __device__ __forceinline__ void stage_rc(int b, int& R, int& C) { const int st = b / 1024, sb = b % 1024, swz = sb ^ (((sb >> 9) & 1) << 5); R = (st >> 1) * 16 + swz / 64; C = (st & 1) * 32 + (swz % 64) / 2; }
__host__ __device__ __forceinline__ int perm32(int rho) { const int n = rho >> 4, i = rho & 15; return 8 * (i >> 2) + 4 * n + (i & 3); }

struct Unit { int pm, pn; };
struct Gemm { const bf16_t* A; const bf16_t* Bt; int lda; int K; };

struct StaticOrder {
    int nM, nN, nwg, G, c, latent;
    __device__ void init(int M, int N, int G_, int c_, int latent_) { nM = M / BM; nN = N / BM; nwg = nM * nN; G = G_; c = c_; latent = latent_; }
    __device__ bool next(int i, Unit& u) const {
        const long L = (long)i * G + c; if (L >= nwg) return false;
        int wgid = (int)L; { const int q = nwg / NXCD, r = nwg % NXCD, xcd = wgid % NXCD, off = wgid / NXCD; wgid = (xcd < r ? xcd * (q + 1) : r * (q + 1) + (xcd - r) * q) + off; }
        const int nig = WGM * nN, gid = wgid / nig, fm = gid * WGM, gsz = (nM - fm) < WGM ? (nM - fm) : WGM;
        u.pm = fm + ((wgid % nig) % gsz); u.pn = (wgid % nig) / gsz;
        if (latent) u.pm += 1 + (u.pm >= 32 ? 1 : 0);
        return true;
    }
};

template <class Epi>
__device__ __forceinline__ void gemm_phase(LAS unsigned char* lds, const Gemm g, const StaticOrder& S, const Epi& E) {
    int tid_ = threadIdx.x; asm volatile("" : "+v"(tid_));
    const int tid = tid_, wid = __builtin_amdgcn_readfirstlane(tid >> 6), lane = tid & 63, wr = wid >> 2, wc = wid & 3, fr = lane & 15, fq = lane >> 4;
    const int K = g.K, nt = K / BK, lda = g.lda;
    unsigned voffA[2], voffB[2];
#pragma unroll
    for (int i = 0; i < 2; ++i) { int R, C; stage_rc(tid * 16 + i * 8192, R, C); const int Rb = Epi::PERM ? ((R & ~31) + perm32(R & 31)) : R;
        voffA[i] = (unsigned)(R * lda + C) * 2u; voffB[i] = (unsigned)(Rb * K + C) * 2u; }
    const size_t kstep = (size_t)(BK * 2);
    const size_t hstepA = (size_t)HALF * lda * 2, hstepB = (size_t)HALF * K * 2;
    const size_t tstepA = 2 * hstepA, tstepB = 2 * hstepB;
    const unsigned ldsw = (unsigned)wid * 1024u;
    const int aoff = lds_byte(wr * 64 + fr, fq * 8), boff = lds_byte(wc * 32 + fr, fq * 8);
#define PG8_SA(b, h) (((b) * 2 + (h)) * HTB)
#define PG8_SB(b, h) ((4 + (b) * 2 + (h)) * HTB)
#define PG8_STAGE(bufoff, gbase, voff) do { _Pragma("unroll") for (int _i = 0; _i < 2; ++_i) \
        __builtin_amdgcn_global_load_lds((const unsigned*)((const char*)(gbase) + (voff)[_i]), (LAS unsigned*)(lds + (bufoff) + ldsw + _i * 8192), 16, 0, 0); } while (0)
#define PG8_LDA(dst, b, h) do { _Pragma("unroll") for (int m = 0; m < 4; ++m) _Pragma("unroll") for (int k = 0; k < 2; ++k) dst[m][k] = *(const LAS bf16x8*)(lds + PG8_SA(b, h) + aoff + m * 2048 + k * 1024); } while (0)
#define PG8_LDB(dst, b, h) do { _Pragma("unroll") for (int n = 0; n < 2; ++n) _Pragma("unroll") for (int k = 0; k < 2; ++k) dst[n][k] = *(const LAS bf16x8*)(lds + PG8_SB(b, h) + boff + n * 2048 + k * 1024); } while (0)
#define PG8_MMA(ai, bj, At, Bt) do { __builtin_amdgcn_s_setprio(1); _Pragma("unroll") for (int m = 0; m < 4; ++m) _Pragma("unroll") for (int n = 0; n < 2; ++n) _Pragma("unroll") for (int k = 0; k < 2; ++k) \
        acc[ai][bj][m][n] = __builtin_amdgcn_mfma_f32_16x16x32_bf16(Bt[n][k], At[m][k], acc[ai][bj][m][n], 0, 0, 0); __builtin_amdgcn_s_setprio(0); } while (0)
#define PG8_WAIT_V(n) asm volatile("s_waitcnt vmcnt(" #n ")" ::: "memory")
#define PG8_WAIT_L(n) asm volatile("s_waitcnt lgkmcnt(" #n ")" ::: "memory")
#define PG8_BAR __builtin_amdgcn_s_barrier()
#define PG8_SCHED __builtin_amdgcn_sched_barrier(0)
    Unit cur, nxt; int ui = 0;
    if (!S.next(0, cur)) return;
    f32x4 acc[2][2][4][2];
#pragma unroll
    for (int a = 0; a < 2; ++a)
#pragma unroll
        for (int b = 0; b < 2; ++b)
#pragma unroll
            for (int m = 0; m < 4; ++m)
#pragma unroll
                for (int n = 0; n < 2; ++n) acc[a][b][m][n] = (f32x4){0.f, 0.f, 0.f, 0.f};
    bf16x8 At[4][2], B0[2][2], B1[2][2];
    const char* cA = (const char*)g.A + (size_t)cur.pm * tstepA; const char* cB = (const char*)g.Bt + (size_t)cur.pn * tstepB;
    PG8_STAGE(PG8_SB(0, 0), cB, voffB); PG8_STAGE(PG8_SB(0, 1), cB + hstepB, voffB); PG8_STAGE(PG8_SA(0, 0), cA, voffA); PG8_STAGE(PG8_SA(0, 1), cA + hstepA, voffA);
    if (wr == 1) PG8_BAR;
    PG8_WAIT_V(2); PG8_BAR;
    PG8_STAGE(PG8_SB(1, 0), cB + kstep, voffB); PG8_STAGE(PG8_SA(1, 0), cA + kstep, voffA); PG8_STAGE(PG8_SB(1, 1), cB + hstepB + kstep, voffB);
    PG8_WAIT_V(6); PG8_BAR;
    for (;;) {
        const bool has_next = S.next(ui + 1, nxt);
        const char* nA = has_next ? (const char*)g.A + (size_t)nxt.pm * tstepA : cA; const char* nB = has_next ? (const char*)g.Bt + (size_t)nxt.pn * tstepB : cB;
        for (int t = 0; t < nt; t += 2) {
            const bool last = (t == nt - 2);
            const char* a1 = cA + (size_t)(t + 1) * kstep;
            const char* a2 = last ? nA : cA + (size_t)(t + 2) * kstep; const char* b2 = last ? nB : cB + (size_t)(t + 2) * kstep;
            const char* a3 = a2 + kstep; const char* b3 = b2 + kstep;
            PG8_LDB(B0, 0, 0); PG8_LDB(B1, 0, 1); PG8_SCHED; PG8_LDA(At, 0, 0); PG8_STAGE(PG8_SA(1, 1), a1 + hstepA, voffA);
            PG8_WAIT_V(8); PG8_WAIT_L(0); PG8_BAR; PG8_MMA(0, 0, At, B0); PG8_MMA(0, 1, At, B1); PG8_BAR; PG8_SCHED;
            PG8_LDA(At, 0, 1); PG8_STAGE(PG8_SB(0, 0), b2, voffB); PG8_STAGE(PG8_SB(0, 1), b2 + hstepB, voffB); PG8_STAGE(PG8_SA(0, 0), a2, voffA);
            PG8_WAIT_V(8); PG8_WAIT_L(0); PG8_BAR; PG8_MMA(1, 0, At, B0); PG8_MMA(1, 1, At, B1); PG8_BAR; PG8_SCHED;
            PG8_LDB(B0, 1, 0); PG8_LDB(B1, 1, 1); PG8_SCHED; PG8_LDA(At, 1, 0); PG8_STAGE(PG8_SA(0, 1), a2 + hstepA, voffA);
            PG8_WAIT_V(8); PG8_WAIT_L(0); PG8_BAR; PG8_MMA(0, 0, At, B0); PG8_MMA(0, 1, At, B1); PG8_BAR; PG8_SCHED;
            PG8_LDA(At, 1, 1); PG8_STAGE(PG8_SB(1, 0), b3, voffB); PG8_STAGE(PG8_SB(1, 1), b3 + hstepB, voffB); PG8_STAGE(PG8_SA(1, 0), a3, voffA);
            PG8_WAIT_V(8); PG8_WAIT_L(0); PG8_BAR; PG8_MMA(1, 0, At, B0); PG8_MMA(1, 1, At, B1); PG8_BAR; PG8_SCHED;
        }
        if (wr == 0) PG8_BAR;
        E(acc, cur, wr, wc, fr, fq);
        if (!has_next) break;
#pragma unroll
        for (int a = 0; a < 2; ++a)
#pragma unroll
            for (int b = 0; b < 2; ++b)
#pragma unroll
                for (int m = 0; m < 4; ++m)
#pragma unroll
                    for (int n = 0; n < 2; ++n) acc[a][b][m][n] = (f32x4){0.f, 0.f, 0.f, 0.f};
        cur = nxt; cA = nA; cB = nB; ++ui;
        if (wr == 1) PG8_BAR;
    }
    PG8_WAIT_V(0);
    PG8_BAR;
#undef PG8_SA
#undef PG8_SB
#undef PG8_STAGE
#undef PG8_LDA
#undef PG8_LDB
#undef PG8_MMA
#undef PG8_WAIT_V
#undef PG8_WAIT_L
#undef PG8_BAR
#undef PG8_SCHED
}

typedef f32x4 Acc[2][2][4][2];

__device__ __forceinline__ void store8(bf16_t* p, f32x4 v0, f32x4 v1) {
    u32x4 w; w.x = cvt_pk_bf16(v0[0], v0[1]); w.y = cvt_pk_bf16(v0[2], v0[3]); w.z = cvt_pk_bf16(v1[0], v1[1]); w.w = cvt_pk_bf16(v1[2], v1[3]);
    *(u32x4*)p = w;
}
__device__ __forceinline__ void rope8(f32x4& v0, f32x4& v1, const LAS f32x2* tab  , int fq) {
    const f32x4 t0 = *(const LAS f32x4*)(tab), t1 = *(const LAS f32x4*)(tab + 2), t2 = *(const LAS f32x4*)(tab + 4), t3 = *(const LAS f32x4*)(tab + 6);
    const float cs[8] = {t0[0], t0[2], t1[0], t1[2], t2[0], t2[2], t3[0], t3[2]};
    const float sn[8] = {t0[1], t0[3], t1[1], t1[3], t2[1], t2[3], t3[1], t3[3]};
    const float sg = (fq < 2) ? -1.f : 1.f;
#pragma unroll
    for (int j = 0; j < 4; ++j) { const float p = __shfl_xor(v0[j], 32); v0[j] = v0[j] * cs[j] + sg * p * sn[j]; }
#pragma unroll
    for (int j = 0; j < 4; ++j) { const float p = __shfl_xor(v1[j], 32); v1[j] = v1[j] * cs[4 + j] + sg * p * sn[4 + j]; }
}

struct EpiIn {
    static constexpr bool PERM = true;
    bf16_t* Z; const LAS f32x2* rope; float* ssq_q; float* ssq_kv;
    __device__ __forceinline__ void operator()(const Acc& acc, const Unit& u, int wr, int wc, int fr, int fq) const {
        const int pn = u.pn, pmb = u.pm % 33;
        const bool ropetile = (pn < 8) || (pn == 15);
        const bool dorope = ropetile && (pmb != 0);
        const bool statt = (pn >= 12 && pn <= 14);
        const float sc = (pn < 4) ? C_DA : 1.f;
        const int t0 = (pmb - 1) * 256;
        const int row0 = u.pm * BM + wr * 64 + fr, col0 = pn * BM + wc * 32 + 8 * fq;
#pragma unroll
        for (int ai = 0; ai < 2; ++ai)
#pragma unroll
            for (int m = 0; m < 4; ++m) {
                const int pos = (wc & 1) ? (16 * m + fr) : ((t0 >> 6) + 2 * ai + wr);
                const LAS f32x2* tab = rope + pos * 16 + 8 * (fq & 1);
                bf16_t* rowp = Z + (size_t)(row0 + ai * HALF + m * 16) * ZW + col0;
                float sq = 0.f;
#pragma unroll
                for (int bj = 0; bj < 2; ++bj) {
                    f32x4 v0 = acc[ai][bj][m][0], v1 = acc[ai][bj][m][1];
                    if (dorope) rope8(v0, v1, tab, fq);
                    v0 = v0 * sc; v1 = v1 * sc;
                    if (statt) { const f32x4 q0 = v0 * v0, q1 = v1 * v1; sq += (q0[0] + q0[1]) + (q0[2] + q0[3]) + (q1[0] + q1[1]) + (q1[2] + q1[3]); }
                    store8(rowp + bj * HALF, v0, v1);
                }
                if (statt) { sq += __shfl_xor(sq, 16); sq += __shfl_xor(sq, 32);
                    if (fq == 0) atomicAdd((pn == 14 ? ssq_kv : ssq_q) + row0 + ai * HALF + m * 16, sq); }
            }
    }
};
struct EpiMq {
    static constexpr bool PERM = true;
    bf16_t* MQ; const LAS f32x2* rope; const float* rstd;
    __device__ __forceinline__ void operator()(const Acc& acc, const Unit& u, int wr, int wc, int fr, int fq) const {
        const int pn = u.pn, pmb = u.pm % 33;
        const int t0 = (pmb - 1) * 256;
        const int row0 = u.pm * BM + wr * 64 + fr, col0 = pn * BM + wc * 32 + 8 * fq;
#pragma unroll
        for (int ai = 0; ai < 2; ++ai) {
#pragma unroll
            for (int m = 0; m < 4; ++m) {
                const int row = row0 + ai * HALF + m * 16;
                const float rs = C_MLA / sqrtf(rstd[row] * (1.f / 512.f) + EPS);
                bf16_t* rowp = MQ + (size_t)row * MQW + col0;
#pragma unroll
                for (int bj = 0; bj < 2; ++bj) {
                    const int gm = (8 * pn + 4 * bj + wc) % 6;
                    f32x4 v0 = acc[ai][bj][m][0], v1 = acc[ai][bj][m][1];
                    if (gm >= 4) {
                        const int pos = (gm == 5) ? (16 * m + fr) : ((t0 >> 6) + 2 * ai + wr);
                        rope8(v0, v1, rope + pos * 16 + 8 * (fq & 1), fq);
                    }
                    v0 = v0 * rs; v1 = v1 * rs;
                    store8(rowp + bj * HALF, v0, v1);
                }
            }
            asm volatile("" ::: "memory");
        }
    }
};
struct EpiKv {
    static constexpr bool PERM = true;
    bf16_t* KV; const float* rstd;
    __device__ __forceinline__ void operator()(const Acc& acc, const Unit& u, int wr, int wc, int fr, int fq) const {
        const int row0 = u.pm * BM + wr * 64 + fr, col0 = u.pn * BM + wc * 32 + 8 * fq;
#pragma unroll
        for (int ai = 0; ai < 2; ++ai)
#pragma unroll
            for (int m = 0; m < 4; ++m) {
                const int row = row0 + ai * HALF + m * 16;
                const float rs = 1.0f / sqrtf(rstd[row] * (1.f / 256.f) + EPS);
                bf16_t* rowp = KV + (size_t)row * KVW + col0;
#pragma unroll
                for (int bj = 0; bj < 2; ++bj) store8(rowp + bj * HALF, acc[ai][bj][m][0] * rs, acc[ai][bj][m][1] * rs);
            }
    }
};
template <bool ADD> struct EpiMerge {
    static constexpr bool PERM = true;
    bf16_t* Y; const bf16_t* G;
    __device__ __forceinline__ void operator()(const Acc& acc, const Unit& u, int wr, int wc, int fr, int fq) const {
        const int row0 = u.pm * BM + wr * 64 + fr, col0 = u.pn * BM + wc * 32 + 8 * fq;
#pragma unroll
        for (int ai = 0; ai < 2; ++ai)
#pragma unroll
        for (int mh = 0; mh < 2; ++mh) {
            u32x4 gw[2][2], yw[2][2];
#pragma unroll
            for (int mm = 0; mm < 2; ++mm) { const int row = row0 + ai * HALF + (2 * mh + mm) * 16;
#pragma unroll
                for (int bj = 0; bj < 2; ++bj) { gw[mm][bj] = *(const u32x4*)(G + (size_t)row * ZW + col0 + bj * HALF);
                    if (ADD) yw[mm][bj] = *(const u32x4*)(Y + (size_t)row * DM + col0 + bj * HALF); } }
            asm volatile("" ::: "memory");
#pragma unroll
            for (int mm = 0; mm < 2; ++mm) { const int m = 2 * mh + mm; const int row = row0 + ai * HALF + m * 16;
                bf16_t* yp = Y + (size_t)row * DM + col0;
#pragma unroll
                for (int bj = 0; bj < 2; ++bj) {
                    const u32x4 g4 = gw[mm][bj];
                    f32x4 s0 = {sigmoidf_(bf_lo(g4.x)), sigmoidf_(bf_hi(g4.x)), sigmoidf_(bf_lo(g4.y)), sigmoidf_(bf_hi(g4.y))};
                    f32x4 s1 = {sigmoidf_(bf_lo(g4.z)), sigmoidf_(bf_hi(g4.z)), sigmoidf_(bf_lo(g4.w)), sigmoidf_(bf_hi(g4.w))};
                    f32x4 v0 = acc[ai][bj][m][0] * s0, v1 = acc[ai][bj][m][1] * s1;
                    if (ADD) { const u32x4 y4 = yw[mm][bj];
                        v0 += (f32x4){bf_lo(y4.x), bf_hi(y4.x), bf_lo(y4.y), bf_hi(y4.y)}; v1 += (f32x4){bf_lo(y4.z), bf_hi(y4.z), bf_lo(y4.w), bf_hi(y4.w)}; }
                    store8(yp + bj * HALF, v0, v1);
                } }
            asm volatile("" ::: "memory");
        }
    }
};
struct EpiRes {
    static constexpr bool PERM = false;
    const float* base; float* out; const float* mod; const float* bada; int goff;
    __device__ __forceinline__ void operator()(const Acc& acc, const Unit& u, int wr, int wc, int fr, int fq) const {
        const int row0 = u.pm * BM + wr * 64 + fr, col0 = u.pn * BM + wc * 32 + 4 * fq;
        const int b = (u.pm >= 33) ? 1 : 0;
        f32x4 gv[2][2];
#pragma unroll
        for (int bj = 0; bj < 2; ++bj)
#pragma unroll
            for (int n = 0; n < 2; ++n) gv[bj][n] = *(const f32x4*)(mod + b * MODW + goff + col0 + bj * HALF + 16 * n) + *(const f32x4*)(bada + goff + col0 + bj * HALF + 16 * n);
#pragma unroll
        for (int ai = 0; ai < 2; ++ai)
#pragma unroll
        for (int mh = 0; mh < 2; ++mh) {
            f32x4 bs[2][2][2];
#pragma unroll
            for (int mm = 0; mm < 2; ++mm) { const int m = 2 * mh + mm; const size_t off = (size_t)r_to_l(row0 + ai * HALF + m * 16) * DM + col0;
#pragma unroll
                for (int bj = 0; bj < 2; ++bj)
#pragma unroll
                    for (int n = 0; n < 2; ++n) bs[mm][bj][n] = *(const f32x4*)(base + off + bj * HALF + 16 * n); }
            asm volatile("" ::: "memory");
#pragma unroll
            for (int mm = 0; mm < 2; ++mm) { const int m = 2 * mh + mm; const size_t off = (size_t)r_to_l(row0 + ai * HALF + m * 16) * DM + col0;
#pragma unroll
                for (int bj = 0; bj < 2; ++bj)
#pragma unroll
                    for (int n = 0; n < 2; ++n) *(f32x4*)(out + off + bj * HALF + 16 * n) = bs[mm][bj][n] + gv[bj][n] * acc[ai][bj][m][n]; }
            asm volatile("" ::: "memory");
        }
    }
};
struct EpiSwiglu {
    static constexpr bool PERM = true;
    bf16_t* ACT;
    __device__ __forceinline__ void operator()(const Acc& acc, const Unit& u, int wr, int wc, int fr, int fq) const {
        const int row0 = u.pm * BM + wr * 64 + fr, col0 = u.pn * HALF + wc * 32 + 8 * fq;
#pragma unroll
        for (int ai = 0; ai < 2; ++ai)
#pragma unroll
            for (int m = 0; m < 4; ++m) {
                const int row = row0 + ai * HALF + m * 16;
                f32x4 o[2];
#pragma unroll
                for (int n = 0; n < 2; ++n) {
                    const f32x4 gt = acc[ai][0][m][n], up = acc[ai][1][m][n];
#pragma unroll
                    for (int j = 0; j < 4; ++j) o[n][j] = gt[j] * sigmoidf_(gt[j]) * up[j];
                }
                store8(ACT + (size_t)row * FF + col0, o[0], o[1]);
            }
    }
};
}

namespace att {
constexpr int NT = ROWS_B / 64;
constexpr int L_KN = 0, KN_B = 16384;
constexpr int L_KR = 32768, KR_B = 8192;
constexpr int L_V = 49152, V_B = 16384;
constexpr int L_WS = 98304;
constexpr int L_Q = 100352;
constexpr float THR = 8.f;
#define SBAR() __builtin_amdgcn_sched_barrier(0)
__device__ __forceinline__ int crow(int r, int hi) { return (r & 3) + 8 * (r >> 2) + 4 * hi; }

__device__ __forceinline__ void partialSM(f32x16& p0, f32x16& p1, float& m_reg, float& alpha) {
    float pmax = p0[0];
#pragma unroll
    for (int r = 1; r < 16; ++r) pmax = fmaxf(pmax, p0[r]);
#pragma unroll
    for (int r = 0; r < 16; ++r) pmax = fmaxf(pmax, p1[r]);
    { auto rr = __builtin_amdgcn_permlane32_swap(__float_as_uint(pmax), __float_as_uint(pmax), false, false);
      pmax = fmaxf(__uint_as_float(rr[0]), __uint_as_float(rr[1])); }
    float mn;
    if (__builtin_expect(__all(pmax - m_reg <= THR), 1)) { mn = m_reg; alpha = 1.f; }
    else { mn = fmaxf(m_reg, pmax); alpha = __builtin_amdgcn_exp2f(m_reg - mn); m_reg = mn; }
#pragma unroll
    for (int r = 0; r < 16; ++r) p0[r] = p0[r] - mn;
#pragma unroll
    for (int r = 0; r < 16; ++r) p1[r] = p1[r] - mn;
#pragma unroll
    for (int r = 0; r < 16; ++r) p0[r] = __builtin_amdgcn_exp2f(p0[r]);
}
__device__ __forceinline__ void partialSM_rel(f32x16& p0, f32x16& p1, float& m_reg, float& alpha, f32x16& negm) {
    float pmax = p0[0];
#pragma unroll
    for (int r = 1; r < 16; ++r) pmax = fmaxf(pmax, p0[r]);
#pragma unroll
    for (int r = 0; r < 16; ++r) pmax = fmaxf(pmax, p1[r]);
    { auto rr = __builtin_amdgcn_permlane32_swap(__float_as_uint(pmax), __float_as_uint(pmax), false, false);
      pmax = fmaxf(__uint_as_float(rr[0]), __uint_as_float(rr[1])); }
    if (__builtin_expect(__all(pmax <= THR), 1)) { alpha = 1.f; }
    else { const float dl = fmaxf(pmax, 0.f); m_reg += dl; alpha = __builtin_amdgcn_exp2f(-dl);
#pragma unroll
        for (int r = 0; r < 16; ++r) { p0[r] -= dl; p1[r] -= dl; }
        const float nm = -m_reg;
#pragma unroll
        for (int r = 0; r < 16; ++r) negm[r] = nm;
        asm volatile("" : "+v"(negm)); }
#pragma unroll
    for (int r = 0; r < 16; ++r) p0[r] = __builtin_amdgcn_exp2f(p0[r]);
}
__device__ __forceinline__ void finishSM(f32x16& p0, f32x16& p1, float alpha, float& l_reg, bf16x8& pa0, bf16x8& pa1, bf16x8& pa2, bf16x8& pa3) {
#pragma unroll
    for (int r = 0; r < 16; ++r) p1[r] = __builtin_amdgcn_exp2f(p1[r]);
    float ps = 0;
#pragma unroll
    for (int r = 0; r < 16; ++r) ps += p0[r];
#pragma unroll
    for (int r = 0; r < 16; ++r) ps += p1[r];
    { auto rr = __builtin_amdgcn_permlane32_swap(__float_as_uint(ps), __float_as_uint(ps), false, false);
      ps = __uint_as_float(rr[0]) + __uint_as_float(rr[1]); }
    l_reg = l_reg * alpha + ps;
#define PK4(P, BASE, OUT) do { unsigned a0 = cvt_pk_bf16(P[BASE + 0], P[BASE + 1]), a1 = cvt_pk_bf16(P[BASE + 2], P[BASE + 3]);   \
    unsigned b0 = cvt_pk_bf16(P[BASE + 4], P[BASE + 5]), b1 = cvt_pk_bf16(P[BASE + 6], P[BASE + 7]);                              \
    u32x4 w = {a0, a1, b0, b1}; OUT = __builtin_bit_cast(bf16x8, w); } while (0)
    PK4(p0, 0, pa0); PK4(p0, 8, pa1); PK4(p1, 0, pa2); PK4(p1, 8, pa3);
#undef PK4
}
template <bool NOPE>
__device__ __forceinline__ void qkt(f32x16& p0, f32x16& p1, const LAS char* Kn, const LAS char* Kr, const bf16x8* qr, const LAS char* qlds, int r32, int hi) {
    p0 = f32x16{}; p1 = f32x16{};
    if (NOPE) {
        const int x = r32 & 15;
#pragma unroll
        for (int d0 = 0; d0 < 8; ++d0) { const int ch = ((2 * d0 + hi) ^ x) << 4;
            const bf16x8 b0 = *(const LAS bf16x8*)(Kn + r32 * 256 + ch);
            const bf16x8 b1 = *(const LAS bf16x8*)(Kn + (32 + r32) * 256 + ch);
            bf16x8 q; if (d0 < 5) q = qr[d0]; else q = *(const LAS bf16x8*)(qlds + (d0 - 5) * 1024);
            p0 = __builtin_amdgcn_mfma_f32_32x32x16_bf16(b0, q, p0, 0, 0, 0);
            p1 = __builtin_amdgcn_mfma_f32_32x32x16_bf16(b1, q, p1, 0, 0, 0); }
    }
    const int f = (r32 >> 1) & 7;
#pragma unroll
    for (int d0 = 0; d0 < 4; ++d0) { const int ch = ((2 * d0 + hi) ^ f) << 4;
        const bf16x8 b0 = *(const LAS bf16x8*)(Kr + r32 * 128 + ch);
        const bf16x8 b1 = *(const LAS bf16x8*)(Kr + (32 + r32) * 128 + ch);
        bf16x8 q; if (NOPE) q = *(const LAS bf16x8*)(qlds + (3 + d0) * 1024); else q = qr[d0];
        p0 = __builtin_amdgcn_mfma_f32_32x32x16_bf16(b0, q, p0, 0, 0, 0);
        p1 = __builtin_amdgcn_mfma_f32_32x32x16_bf16(b1, q, p1, 0, 0, 0); }
}
template <bool NOPE>
__device__ __forceinline__ void qkt_pipe(f32x16& p0, f32x16& p1, const LAS char* Kn, const LAS char* Kr, const bf16x8* qr, const LAS char* qlds, int r32, int hi, const f32x16& negm) {
    constexpr int NC = NOPE ? 6 : 2;
    const int x = r32 & 15, f = (r32 >> 1) & 7;
    const LAS char* kn0 = Kn + r32 * 256; const LAS char* kr0 = Kr + r32 * 128;
    bf16x8 ka[4], kb[4], qa[2], qb[2];
#define LOADC(k, q, c) do { _Pragma("unroll") for (int i_ = 0; i_ < 2; ++i_) { const int d0 = 2 * (c) + i_; \
        if (NOPE && d0 < 8) { const int ch = ((2 * d0 + hi) ^ x) << 4; k[2 * i_] = *(const LAS bf16x8*)(kn0 + ch); k[2 * i_ + 1] = *(const LAS bf16x8*)(kn0 + 32 * 256 + ch); } \
        else { const int dr = d0 - (NOPE ? 8 : 0); const int ch = ((2 * dr + hi) ^ f) << 4; k[2 * i_] = *(const LAS bf16x8*)(kr0 + ch); k[2 * i_ + 1] = *(const LAS bf16x8*)(kr0 + 32 * 128 + ch); } \
        if (NOPE) { if (d0 < 5) q[i_] = qr[d0]; else q[i_] = *(const LAS bf16x8*)(qlds + (d0 - 5) * 1024); } else q[i_] = qr[d0]; } } while (0)
#define MMAC(k, q) do { _Pragma("unroll") for (int i_ = 0; i_ < 2; ++i_) { \
        p0 = __builtin_amdgcn_mfma_f32_32x32x16_bf16(k[2 * i_], q[i_], p0, 0, 0, 0); p1 = __builtin_amdgcn_mfma_f32_32x32x16_bf16(k[2 * i_ + 1], q[i_], p1, 0, 0, 0); } } while (0)
    LOADC(ka, qa, 0); LOADC(kb, qb, 1); SBAR();
    if (NOPE) { p0 = f32x16{}; p1 = f32x16{}; p0 = __builtin_amdgcn_mfma_f32_32x32x16_bf16(ka[0], qa[0], p0, 0, 0, 0); p1 = __builtin_amdgcn_mfma_f32_32x32x16_bf16(ka[1], qa[0], p1, 0, 0, 0); }
    else { p0 = __builtin_amdgcn_mfma_f32_32x32x16_bf16(ka[0], qa[0], negm, 0, 0, 0); p1 = __builtin_amdgcn_mfma_f32_32x32x16_bf16(ka[1], qa[0], negm, 0, 0, 0); }
    p0 = __builtin_amdgcn_mfma_f32_32x32x16_bf16(ka[2], qa[1], p0, 0, 0, 0); p1 = __builtin_amdgcn_mfma_f32_32x32x16_bf16(ka[3], qa[1], p1, 0, 0, 0); SBAR();
    if (NC > 2) {
        LOADC(ka, qa, 2); SBAR(); MMAC(kb, qb); SBAR();
        LOADC(kb, qb, 3); SBAR(); MMAC(ka, qa); SBAR();
        LOADC(ka, qa, 4); SBAR(); MMAC(kb, qb); SBAR();
        LOADC(kb, qb, 5); SBAR(); MMAC(ka, qa); SBAR();
        MMAC(kb, qb); SBAR();
    } else {
        MMAC(kb, qb); SBAR();
    }
#undef LOADC
#undef MMAC
}
__device__ __forceinline__ int v_st(int k, int c) { const int kk = (k & ~0xC) | ((k & 4) << 1) | ((k & 8) >> 1); return ((kk >> 3) * 4 + (c >> 5)) * 512 + ((kk & 7) * 32 + (c & 31)) * 2; }
__device__ __forceinline__ int v_rd_base(int lane) { return ((lane & 3) << 3) | (((lane >> 2) & 3) << 6) | (((lane >> 4) & 1) << 5) | (((lane >> 5) & 1) << 8); }
constexpr int v_rd_off(int d0, int ks, int half) { return d0 * 512 + ks * 4096 + half * 2048; }
template <int OFF> __device__ __forceinline__ s16x4 tr_read(int vb) {
    s16x4 r; asm volatile("ds_read_b64_tr_b16 %0, %1 offset:%2" : "=&v"(r) : "v"(vb), "i"(OFF) : "memory"); return r;
}
template <int D0> __device__ __forceinline__ void pv_one(f32x16& od, int vb, bf16x8 pa0, bf16x8 pa1, bf16x8 pa2, bf16x8 pa3) {
    const s16x4 l0 = tr_read<v_rd_off(D0, 0, 0)>(vb), h0 = tr_read<v_rd_off(D0, 0, 1)>(vb), l1 = tr_read<v_rd_off(D0, 1, 0)>(vb), h1 = tr_read<v_rd_off(D0, 1, 1)>(vb);
    const s16x4 l2 = tr_read<v_rd_off(D0, 2, 0)>(vb), h2 = tr_read<v_rd_off(D0, 2, 1)>(vb), l3 = tr_read<v_rd_off(D0, 3, 0)>(vb), h3 = tr_read<v_rd_off(D0, 3, 1)>(vb);
    asm volatile("s_waitcnt lgkmcnt(0)" ::: "memory"); SBAR();
#define PK(L, H) (bf16x8){L[0], L[1], L[2], L[3], H[0], H[1], H[2], H[3]}
    od = __builtin_amdgcn_mfma_f32_32x32x16_bf16(pa0, PK(l0, h0), od, 0, 0, 0);
    od = __builtin_amdgcn_mfma_f32_32x32x16_bf16(pa1, PK(l1, h1), od, 0, 0, 0);
    od = __builtin_amdgcn_mfma_f32_32x32x16_bf16(pa2, PK(l2, h2), od, 0, 0, 0);
    od = __builtin_amdgcn_mfma_f32_32x32x16_bf16(pa3, PK(l3, h3), od, 0, 0, 0);
#undef PK
}
__device__ __forceinline__ void pv_d0(f32x16* o, int vb, bf16x8 pa0, bf16x8 pa1, bf16x8 pa2, bf16x8 pa3) {
    pv_one<0>(o[0], vb, pa0, pa1, pa2, pa3); pv_one<1>(o[1], vb, pa0, pa1, pa2, pa3); pv_one<2>(o[2], vb, pa0, pa1, pa2, pa3); pv_one<3>(o[3], vb, pa0, pa1, pa2, pa3);
}

template <bool NOPE, int ldkn, int ldkr, int ldv, bool TWO>
__device__ __forceinline__ void attn_pass(LAS char* lds, const bf16_t* Qw, const bf16_t* Kn, const bf16_t* Kr, const bf16_t* V, f32x16 (&o)[4]) {
    int tid_ = threadIdx.x; asm volatile("" : "+v"(tid_));
    const int tid = tid_, lane = tid & 63, r32 = lane & 31, hi = lane >> 5; const int wid = __builtin_amdgcn_readfirstlane(tid >> 6);
    LAS float* ws = (LAS float*)(lds + L_WS) + wid * 64; LAS float* li_l = ws; LAS float* al_l = ws + 32;
    constexpr int NQ = NOPE ? 5 : 4;
    bf16x8 qr[NQ];
#pragma unroll
    for (int d0 = 0; d0 < NQ; ++d0) qr[d0] = *(const bf16x8*)(Qw + d0 * 16);
    const LAS char* qlds = lds + L_Q + wid * 7168 + lane * 16;
    if (NOPE) {
#pragma unroll
        for (int d0 = 0; d0 < 7; ++d0) *(LAS bf16x8*)(lds + L_Q + wid * 7168 + lane * 16 + d0 * 1024) = *(const bf16x8*)(Qw + (5 + d0) * 16);
    }
    unsigned okn0 = 0, okn1 = 0;
    if (NOPE) {
        { const int b = (wid * 2) * 1024 + lane * 16, row = b >> 8, ch = ((b & 255) >> 4) ^ (row & 15); okn0 = (unsigned)(row * ldkn + ch * 8) * 2u; }
        { const int b = (wid * 2 + 1) * 1024 + lane * 16, row = b >> 8, ch = ((b & 255) >> 4) ^ (row & 15); okn1 = (unsigned)(row * ldkn + ch * 8) * 2u; }
    }
    unsigned okr; { const int b = wid * 1024 + lane * 16, row = b >> 7, ch = ((b & 127) >> 4) ^ ((row >> 1) & 7); okr = (unsigned)(row * ldkr + ch * 8) * 2u; }
    unsigned ov0, ov1;
    { const int off = (wid * 2) * 1024 + lane * 16, sub = off >> 9, w = (off & 511) >> 1, kk = (sub >> 2) * 8 + (w >> 5), k = kk  , c = (sub & 3) * 32 + (w & 31);
      ov0 = (unsigned)(k * ldv + c) * 2u; }
    { const int off = (wid * 2 + 1) * 1024 + lane * 16, sub = off >> 9, w = (off & 511) >> 1, kk = (sub >> 2) * 8 + (w >> 5), k = kk  , c = (sub & 3) * 32 + (w & 31);
      ov1 = (unsigned)(k * ldv + c) * 2u; }
    const char* bkn = (const char*)Kn; const char* bkr = (const char*)Kr; const char* bv = (const char*)V;
    const size_t kn_step = (size_t)64 * ldkn * 2, kr_step = (size_t)64 * ldkr * 2, v_step = (size_t)64 * ldv * 2;
    const unsigned wo1 = (unsigned)wid * 1024u, wo2 = (unsigned)wid * 2048u;
#define GLDS(src, dstoff) __builtin_amdgcn_global_load_lds((const unsigned*)(src), (LAS unsigned*)(lds + (dstoff)), 16, 0, 0)
#define DMA_TILE(kb, vslot) do { \
    if (NOPE) { GLDS(bkn + okn0, L_KN + (kb) * KN_B + wo2); GLDS(bkn + okn1, L_KN + (kb) * KN_B + wo2 + 1024u); bkn += kn_step; } \
    GLDS(bkr + okr, L_KR + (kb) * KR_B + wo1); bkr += kr_step; \
    GLDS(bv + ov0, L_V + (vslot) + wo2); GLDS(bv + ov1, L_V + (vslot) + wo2 + 1024u); bv += v_step; } while (0)
    constexpr int PF_AHEAD = 3;
    const char* pfp = nullptr;
    if (!NOPE) { const int li = tid % 192; pfp = (li < 64) ? (const char*)(Kr + (size_t)li * ldkr) : (const char*)(V + (size_t)((li - 64) >> 1) * ldv + ((li - 64) & 1) * 64);
                 pfp += (size_t)PF_AHEAD * kr_step; }
    int pft = PF_AHEAD;
#define PREFETCH() do { if (!NOPE) { const char* p_ = (pft < NT) ? pfp : pfp - (size_t)PF_AHEAD * kr_step; __builtin_amdgcn_global_load_lds((const unsigned*)p_, (LAS unsigned*)(lds + L_Q + wid * 256), 4, 0, 0); pfp += kr_step; ++pft; } } while (0)
#define WAITSYNC() do { asm volatile("s_waitcnt vmcnt(0)" ::: "memory"); __syncthreads(); } while (0)
#define RESC(a) do { if (__any((a) < 1.f)) { if (hi == 0) al_l[r32] = (a); asm volatile("s_waitcnt lgkmcnt(0)" ::: "memory"); \
    _Pragma("unroll") for (int d = 0; d < 4; ++d) _Pragma("unroll") for (int r = 0; r < 16; ++r) o[d][r] *= al_l[crow(r, hi)]; } } while (0)
    const LAS char* Kn0 = lds + L_KN; const LAS char* Kn1 = lds + L_KN + KN_B; const LAS char* Kr0 = lds + L_KR; const LAS char* Kr1 = lds + L_KR + KR_B;
    const int vb0 = (int)(unsigned)(uintptr_t)(lds + L_V) + v_rd_base(lane);
    float m_reg = -1e30f, l_reg = 0.f;
#pragma unroll
    for (int d = 0; d < 4; ++d) o[d] = f32x16{};
    f32x16 pA0, pA1, pB0, pB1; float alA, alB; bf16x8 pa0, pa1, pa2, pa3;
    int sl_prev = 0, sl_cur = V_B, sl_next = 2 * V_B;
#define ROT() do { const int t_ = sl_prev; sl_prev = sl_cur; sl_cur = sl_next; sl_next = t_; } while (0)
    if (TWO) {
    DMA_TILE(0, 0);
    WAITSYNC();
    DMA_TILE(1, V_B);
    qkt<NOPE>(pA0, pA1, Kn0, Kr0, qr, qlds, r32, hi); partialSM(pA0, pA1, m_reg, alA);
    WAITSYNC();
    for (int j = 1; j + 1 < NT; j += 2) {
        DMA_TILE(0, sl_next);
        SBAR(); qkt<NOPE>(pB0, pB1, Kn1, Kr1, qr, qlds, r32, hi);
        finishSM(pA0, pA1, alA, l_reg, pa0, pa1, pa2, pa3); SBAR();
        pv_d0(o, vb0 + sl_prev, pa0, pa1, pa2, pa3); partialSM(pB0, pB1, m_reg, alB);
        RESC(alB);
        WAITSYNC(); ROT();
        DMA_TILE(1, sl_next);
        SBAR(); qkt<NOPE>(pA0, pA1, Kn0, Kr0, qr, qlds, r32, hi);
        finishSM(pB0, pB1, alB, l_reg, pa0, pa1, pa2, pa3); SBAR();
        pv_d0(o, vb0 + sl_prev, pa0, pa1, pa2, pa3); partialSM(pA0, pA1, m_reg, alA);
        RESC(alA);
        WAITSYNC(); ROT();
    }
    SBAR(); qkt<NOPE>(pB0, pB1, Kn1, Kr1, qr, qlds, r32, hi);
    finishSM(pA0, pA1, alA, l_reg, pa0, pa1, pa2, pa3); SBAR();
    pv_d0(o, vb0 + sl_prev, pa0, pa1, pa2, pa3); partialSM(pB0, pB1, m_reg, alB);
    RESC(alB);
    finishSM(pB0, pB1, alB, l_reg, pa0, pa1, pa2, pa3); SBAR();
    pv_d0(o, vb0 + sl_cur, pa0, pa1, pa2, pa3);
    } else {
        const int grp = wid >> 2;
#define BAR() __builtin_amdgcn_s_barrier()
#define VMW() do { if (NOPE) asm volatile("s_waitcnt vmcnt(0)" ::: "memory"); else asm volatile("s_waitcnt vmcnt(1)" ::: "memory"); } while (0)
#define SMB0() do { partialSM(pA0, pA1, m_reg, alA); RESC(alA); finishSM(pA0, pA1, alA, l_reg, pa0, pa1, pa2, pa3); } while (0)
#define SMB() do { if (NOPE) partialSM(pA0, pA1, m_reg, alA); else partialSM_rel(pA0, pA1, m_reg, alA, negm); RESC(alA); finishSM(pA0, pA1, alA, l_reg, pa0, pa1, pa2, pa3); } while (0)
        s16x4 va[8], vbq[8]; f32x16 negm = f32x16{};
#define VLD(dst, D0, vb) do { dst[0] = tr_read<v_rd_off(D0, 0, 0)>(vb); dst[1] = tr_read<v_rd_off(D0, 0, 1)>(vb); dst[2] = tr_read<v_rd_off(D0, 1, 0)>(vb); dst[3] = tr_read<v_rd_off(D0, 1, 1)>(vb); \
                               dst[4] = tr_read<v_rd_off(D0, 2, 0)>(vb); dst[5] = tr_read<v_rd_off(D0, 2, 1)>(vb); dst[6] = tr_read<v_rd_off(D0, 3, 0)>(vb); dst[7] = tr_read<v_rd_off(D0, 3, 1)>(vb); } while (0)
#define PKV(L, H) (bf16x8){L[0], L[1], L[2], L[3], H[0], H[1], H[2], H[3]}
#define VMM(od, src) do { od = __builtin_amdgcn_mfma_f32_32x32x16_bf16(pa0, PKV(src[0], src[1]), od, 0, 0, 0); od = __builtin_amdgcn_mfma_f32_32x32x16_bf16(pa1, PKV(src[2], src[3]), od, 0, 0, 0); \
                           od = __builtin_amdgcn_mfma_f32_32x32x16_bf16(pa2, PKV(src[4], src[5]), od, 0, 0, 0); od = __builtin_amdgcn_mfma_f32_32x32x16_bf16(pa3, PKV(src[6], src[7]), od, 0, 0, 0); } while (0)
#define LGK(n) asm volatile("s_waitcnt lgkmcnt(" #n ")" ::: "memory")
#define MBLOCK(KN, KR, vslot) do { const int vb_ = vb0 + (vslot); if (!NOPE) { VLD(va, 0, vb_); SBAR(); } \
            qkt_pipe<NOPE>(pA0, pA1, KN, KR, qr, qlds, r32, hi, negm); SBAR(); if (NOPE) { VLD(va, 0, vb_); SBAR(); } \
            VLD(vbq, 1, vb_); LGK(8); SBAR(); VMM(o[0], va); SBAR(); \
            VLD(va, 2, vb_); LGK(8); SBAR(); VMM(o[1], vbq); SBAR(); \
            VLD(vbq, 3, vb_); LGK(8); SBAR(); VMM(o[2], va); SBAR(); \
            LGK(0); SBAR(); VMM(o[3], vbq); SBAR(); } while (0)
        bf16x8 dka[4], dkb[4];
#define DA_LOADK(k, c, KR) do { _Pragma("unroll") for (int i_ = 0; i_ < 2; ++i_) { const int ch_ = ((2 * (2 * (c) + i_) + hi) ^ ((r32 >> 1) & 7)) << 4; \
        k[2 * i_] = *(const LAS bf16x8*)((KR) + r32 * 128 + ch_); k[2 * i_ + 1] = *(const LAS bf16x8*)((KR) + (32 + r32) * 128 + ch_); } } while (0)
#define MBLOCK_DA(KR, vslot) do { const int vb_ = vb0 + (vslot); SBAR(); DA_LOADK(dka, 0, KR); DA_LOADK(dkb, 1, KR); SBAR(); \
            LGK(8); SBAR(); VMM(o[0], va); SBAR(); \
            VLD(vbq, 1, vb_); SBAR(); \
            pA0 = __builtin_amdgcn_mfma_f32_32x32x16_bf16(dka[0], qr[0], negm, 0, 0, 0); pA1 = __builtin_amdgcn_mfma_f32_32x32x16_bf16(dka[1], qr[0], negm, 0, 0, 0); \
            pA0 = __builtin_amdgcn_mfma_f32_32x32x16_bf16(dka[2], qr[1], pA0, 0, 0, 0); pA1 = __builtin_amdgcn_mfma_f32_32x32x16_bf16(dka[3], qr[1], pA1, 0, 0, 0); \
            pA0 = __builtin_amdgcn_mfma_f32_32x32x16_bf16(dkb[0], qr[2], pA0, 0, 0, 0); pA1 = __builtin_amdgcn_mfma_f32_32x32x16_bf16(dkb[1], qr[2], pA1, 0, 0, 0); \
            pA0 = __builtin_amdgcn_mfma_f32_32x32x16_bf16(dkb[2], qr[3], pA0, 0, 0, 0); pA1 = __builtin_amdgcn_mfma_f32_32x32x16_bf16(dkb[3], qr[3], pA1, 0, 0, 0); SBAR(); \
            VLD(va, 2, vb_); LGK(8); SBAR(); VMM(o[1], vbq); SBAR(); \
            VLD(vbq, 3, vb_); LGK(8); SBAR(); VMM(o[2], va); SBAR(); \
            LGK(0); SBAR(); VMM(o[3], vbq); SBAR(); } while (0)
#define VPRE0(vslot) do { if (!NOPE) { SBAR(); VLD(va, 0, vb0 + (vslot)); SBAR(); } } while (0)
        DMA_TILE(0, 0);
        if (grp == 1) DMA_TILE(1, V_B);
        asm volatile("s_waitcnt vmcnt(0)" ::: "memory"); __syncthreads();
        if (grp == 1) { __builtin_amdgcn_s_setprio(1); BAR(); }
        SBAR(); qkt<NOPE>(pA0, pA1, Kn0, Kr0, qr, qlds, r32, hi); SBAR();
        if (grp == 0) { DMA_TILE(1, V_B); PREFETCH(); }
        if (grp == 1) VMW();
        BAR();
        if (grp == 1) { DMA_TILE(0, 2 * V_B); PREFETCH(); }
        SMB0();
        if (!NOPE) { const float nm = -m_reg;
#pragma unroll
          for (int r = 0; r < 16; ++r) negm[r] = nm;
          asm volatile("" : "+v"(negm)); }
        VPRE0(0);
        if (grp == 0) VMW();
        BAR();
        int s0 = 0, s1 = V_B, s2 = 2 * V_B;
#define ROT3() do { const int t_ = s0; s0 = s1; s1 = s2; s2 = t_; } while (0)
        for (int j = 1; j + 1 < NT; j += 2) {
            if (NOPE) MBLOCK(Kn1, Kr1, s0); else MBLOCK_DA(Kr1, s0);
            if (grp == 1) VMW();
            BAR();
            if (grp == 0) { DMA_TILE(0, s2); PREFETCH(); }
            if (grp == 1) { DMA_TILE(1, s0); PREFETCH(); }
            SMB();
            VPRE0(s1);
            if (grp == 0) VMW();
            BAR();
            ROT3();
            if (NOPE) MBLOCK(Kn0, Kr0, s0); else MBLOCK_DA(Kr0, s0);
            if (grp == 1) VMW();
            BAR();
            if (grp == 0) { DMA_TILE(1, s2); PREFETCH(); }
            if (grp == 1 && j + 3 < NT) { DMA_TILE(0, s0); PREFETCH(); }
            SMB();
            VPRE0(s1);
            if (grp == 0) VMW();
            BAR();
            ROT3();
        }
        if (NOPE) MBLOCK(Kn1, Kr1, s0); else MBLOCK_DA(Kr1, s0);
        if (grp == 1) VMW();
        BAR();
        SMB();
        VPRE0(s1);
        BAR();
        ROT3();
        { const int vb_ = vb0 + s0; if (NOPE) VLD(va, 0, vb_); VLD(vbq, 1, vb_); LGK(8); SBAR(); VMM(o[0], va); SBAR();
          VLD(va, 2, vb_); LGK(8); SBAR(); VMM(o[1], vbq); SBAR();
          VLD(vbq, 3, vb_); LGK(8); SBAR(); VMM(o[2], va); SBAR();
          LGK(0); SBAR(); VMM(o[3], vbq); SBAR(); }
        if (grp == 0) BAR();
        __builtin_amdgcn_s_setprio(0);
#undef BAR
#undef VMW
#undef SMB
#undef SMB0
#undef VLD
#undef PKV
#undef VMM
#undef LGK
#undef MBLOCK
#undef MBLOCK_DA
#undef DA_LOADK
#undef VPRE0
#undef ROT3
    }
    if (hi == 0) li_l[r32] = l_reg; asm volatile("s_waitcnt lgkmcnt(0)" ::: "memory");
#pragma unroll
    for (int r = 0; r < 16; ++r) { const float rl = __builtin_amdgcn_rcpf(li_l[crow(r, hi)]);
#pragma unroll
        for (int d = 0; d < 4; ++d) o[d][r] *= rl; }
    asm volatile("s_waitcnt vmcnt(0)" ::: "memory");
    __syncthreads();
#undef GLDS
#undef DMA_TILE
#undef WAITSYNC
#undef PREFETCH
#undef RESC
#undef ROT
}
#undef SBAR
}

#define XB_TMO      128
#define XB_XCNT(j)  (256  + 64 * (j))
#define XB_XSUB(j)  (1280 + 64 * (j))
#define XB_XGEN(j)  (2304 + 64 * (j))
#define XB_TOP      3328
#define XB_TOPGEN   3392
#define XCD_BAR_WORDS 3456
#define XB_SPIN_CAP (1u << 18)

__device__ __forceinline__ unsigned xb_ld(unsigned* p)              { return __hip_atomic_load(p, __ATOMIC_RELAXED, __HIP_MEMORY_SCOPE_AGENT); }
__device__ __forceinline__ unsigned xb_add(unsigned* p, unsigned v) { return __hip_atomic_fetch_add(p, v, __ATOMIC_RELAXED, __HIP_MEMORY_SCOPE_AGENT); }
__device__ __forceinline__ unsigned xb_xcc_id() { return (unsigned)__builtin_amdgcn_s_getreg((3 << 11) | 20) & 0xFu; }
#define XB_SPIN(cond, bar) do { unsigned _sp = 0; while (cond) { __builtin_amdgcn_s_sleep(1); \
    if ((++_sp & 255u) == 0u) { if (xb_ld(&(bar)[XB_TMO])) break; if (_sp > XB_SPIN_CAP) { atomicAdd(&(bar)[XB_TMO], 1u); break; } } } } while (0)

struct XcdBarrier {
    unsigned* bar; unsigned x;
    volatile LAS unsigned* st;
};

__device__ __forceinline__ XcdBarrier xcd_barrier_post(unsigned* bar, volatile LAS unsigned* st) {
    XcdBarrier b; b.bar = bar; b.x = xb_xcc_id(); b.st = st;
    if (threadIdx.x == 0) (void)xb_add(&bar[XB_XCNT(b.x)], 1u);
    return b;
}
__device__ __forceinline__ void xcd_barrier_complete(unsigned* bar, unsigned x, unsigned& nloc, unsigned& nx) {
    const unsigned G = gridDim.x * gridDim.y * gridDim.z;
    unsigned sum, cnt, mine, sp = 0u;
    for (;;) {
        sum = 0u; cnt = 0u; mine = 0u;
#pragma unroll
        for (unsigned j = 0; j < 16; ++j) { const unsigned c = xb_ld(&bar[XB_XCNT(j)]); sum += c; cnt += (c > 0u) ? 1u : 0u; mine = (j == x) ? c : mine; }
        if (sum == G) break;
        __builtin_amdgcn_s_sleep(1);
        if ((++sp & 255u) == 0u) { if (xb_ld(&bar[XB_TMO])) break; if (sp > XB_SPIN_CAP) { atomicAdd(&bar[XB_TMO], 1u); break; } }
    }
    nloc = mine > 0u ? mine : 1u; nx = cnt > 0u ? cnt : 1u;
}

__device__ __forceinline__ void xcd_barrier(const XcdBarrier& b) {
    asm volatile("s_waitcnt vmcnt(0)" ::: "memory");
    __syncthreads();
    if (threadIdx.x == 0) {
        unsigned* bar = b.bar;
        __builtin_amdgcn_s_waitcnt(0);
        unsigned nloc = b.st[0], nx = b.st[1];
        if (nloc == 0u) { xcd_barrier_complete(bar, b.x, nloc, nx); b.st[0] = nloc; b.st[1] = nx; }
        const unsigned old = xb_add(&bar[XB_XSUB(b.x)], 1u);
        const unsigned gen = old / nloc;
        if (old + 1u == (gen + 1u) * nloc) {
            __builtin_amdgcn_fence(__ATOMIC_RELEASE, "agent");
            asm volatile("s_waitcnt vmcnt(0)" ::: "memory");
            const unsigned og = xb_add(&bar[XB_TOP], 1u);
            const unsigned tg = og / nx;
            if (og + 1u == (tg + 1u) * nx) xb_add(&bar[XB_TOPGEN], 1u);
            else XB_SPIN(xb_ld(&bar[XB_TOPGEN]) == tg, bar);
            __builtin_amdgcn_fence(__ATOMIC_ACQUIRE, "agent");
            xb_add(&bar[XB_XGEN(b.x)], 1u);
            asm volatile("s_waitcnt vmcnt(0)" ::: "memory");
        } else {
            XB_SPIN(xb_ld(&bar[XB_XGEN(b.x)]) == gen, bar);
            __builtin_amdgcn_fence(__ATOMIC_ACQUIRE, "agent");
            asm volatile("s_waitcnt vmcnt(0)" ::: "memory");
        }
    }
    __syncthreads();
}


constexpr int N_PHASES_K = 12;
struct Args { const float* in[22]; float* out; unsigned char* ws; int ph_lo, ph_hi; };

__device__ __forceinline__ void p0_tr_item(const float* W, int K, int N, int k0, int n0, bf16_t* WT, int drow0, const float* gk, LAS float* scr, int lane) {
#pragma unroll 8
    for (int i = 0; i < 32; ++i) { const int kk = 2 * i + (lane >> 5); float v = W[(size_t)(k0 + kk) * N + n0 + (lane & 31)]; if (gk) v *= gk[k0 + kk]; scr[kk * 33 + (lane & 31)] = v; }
    asm volatile("s_waitcnt lgkmcnt(0)" ::: "memory");
    const int c = lane & 7;
#pragma unroll
    for (int j = 0; j < 4; ++j) { const int n = (lane >> 3) + 8 * j; const LAS float* s = scr + (8 * c) * 33 + n;
        u32x4 o; o.x = cvt_pk_bf16(s[0 * 33], s[1 * 33]); o.y = cvt_pk_bf16(s[2 * 33], s[3 * 33]); o.z = cvt_pk_bf16(s[4 * 33], s[5 * 33]); o.w = cvt_pk_bf16(s[6 * 33], s[7 * 33]);
        *(u32x4*)(WT + (size_t)(drow0 + n) * K + k0 + 8 * c) = o; }
    asm volatile("s_waitcnt lgkmcnt(0)" ::: "memory");
}

template <int MODE>
__device__ __forceinline__ void norm_row(const float* xrow, const float* g, const float* mod_s, const float* bada, int shoff, int scoff, void* orow, int lane) {
    const f32x4* xr = (const f32x4*)xrow + lane;
    f32x4 v[8]; float s2 = 0.f;
#pragma unroll
    for (int j = 0; j < 8; ++j) { v[j] = xr[64 * j]; s2 += (v[j].x * v[j].x + v[j].y * v[j].y) + (v[j].z * v[j].z + v[j].w * v[j].w); }
    const float rstd = 1.0f / sqrtf(wave_sum(s2) * (1.f / DM) + EPS);
#pragma unroll
    for (int j = 0; j < 8; ++j) {
        const int c = (lane + 64 * j) * 4;
        const f32x4 gg = *(const f32x4*)(g + c);
        f32x4 y = v[j] * rstd * gg;
        if (MODE == 0) {
            const f32x4 sh = *(const f32x4*)(mod_s + shoff + c) + *(const f32x4*)(bada + shoff + c);
            const f32x4 sc = *(const f32x4*)(mod_s + scoff + c) + *(const f32x4*)(bada + scoff + c);
            y = y * (sc + 1.0f) + sh;
            u32x2 w; w.x = cvt_pk_bf16(y.x, y.y); w.y = cvt_pk_bf16(y.z, y.w);
            *((u32x2*)orow + lane + 64 * j) = w;
        } else {
            *((f32x4*)orow + lane + 64 * j) = y;
        }
    }
}

__global__ void __launch_bounds__(NWAVES * 64, 2) mk_fwd(Args args) {
    extern __shared__ __attribute__((aligned(16))) unsigned char lds_raw[];
    LAS unsigned char* lds = (LAS unsigned char*)lds_raw;
    const int tid = threadIdx.x, lane = tid & 63, wave = __builtin_amdgcn_readfirstlane(tid >> 6);
    const int G = gridDim.x, bx = blockIdx.x;
    const int gw = bx * NWAVES + wave, NGW = G * NWAVES;
#define ws (args.ws)
#define xin (args.in[0])
#define cvec (args.in[1])
#define ctx (args.in[2])
#define c_ctx (args.in[3])
#define w_ada (args.in[4])
#define b_ada (args.in[5])
#define norm1_g (args.in[6])
#define norm2_g (args.in[7])
#define w_in (args.in[8])
#define da_lambda (args.in[9])
#define da_g (args.in[10])
#define mla_q_g (args.in[11])
#define mla_kv_g (args.in[12])
#define w_uq (args.in[13])
#define w_ukv (args.in[14])
#define w_o_da (args.in[15])
#define w_o_mla (args.in[16])
#define w_out (args.in[17])
#define w_gate (args.in[18])
#define w_up (args.in[19])
#define w_down (args.in[20])
#define final_g (args.in[21])
#define out (args.out)
#define mod ((float*)(ws + WS_MOD))
#define rope ((f32x2*)(ws + WS_ROPE))
#define rstd_q ((float*)(ws + WS_RSQ))
#define rstd_kv ((float*)(ws + WS_RSKV))
#define WinT ((bf16_t*)(ws + WS_WIN))
#define WuqT ((bf16_t*)(ws + WS_WUQ))
#define WukvT ((bf16_t*)(ws + WS_WUKV))
#define WodaT ((bf16_t*)(ws + WS_WODA))
#define WomlaT ((bf16_t*)(ws + WS_WOMLA))
#define WoutT ((bf16_t*)(ws + WS_WOUT))
#define WguT ((bf16_t*)(ws + WS_WGU))
#define WdT ((bf16_t*)(ws + WS_WD))
#define HB ((bf16_t*)(ws + WS_H))
#define Z ((bf16_t*)(ws + WS_Z))
#define MQ ((bf16_t*)(ws + WS_MQ))
#define KV HB
#define Y HB
#define H2 HB
#define ACT Z
#define stash ((float*)((unsigned char*)out + OUT_STASH))
#define OMLA ((bf16_t*)((unsigned char*)out + OUT_OMLA))
#define ODA ((bf16_t*)((unsigned char*)out + OUT_ODA))

    if (tid < 64) ((LAS unsigned*)(lds + LDS_MISC))[tid] = 0u;
    __syncthreads();
    XcdBarrier xbar = xcd_barrier_post((unsigned*)(ws + WS_BAR), (volatile LAS unsigned*)(lds + LDS_MISC));
    const int lo = args.ph_lo, hi = args.ph_hi;
#ifndef PH_MASK
#define PH_MASK 0xFFF
#endif
#define IN(k) (((PH_MASK >> (k)) & 1) && lo <= (k) && (k) < hi)
#ifndef PROBE_DUP
#define PROBE_DUP -1
#endif
#define REP(k) for (int rep_ = 0; rep_ < ((PROBE_DUP) == (k) ? 2 : 1); ++rep_)
#define SEAM(k) do { if (IN(k) && IN((k) + 1)) { if (lo < 0) cg::this_grid().sync(); xcd_barrier(xbar); } } while (0)

    if (IN(0)) REP(0) {
        LAS float* scr = (LAS float*)(lds + wave * 16384);
        constexpr int I_IN = 32 * 250, I_UQ = 8 * 48, I_UKV = 4 * 64, I_O = 16 * 64, I_OUT = 32 * 64, I_G = 32 * 176, I_D = 88 * 64;
        constexpr int I_PAD = 192, I_ROPE = 32, I_ADA = 32 * 48;
        constexpr int NITEMS = I_ADA + I_IN + I_UQ + I_UKV + 2 * I_O + I_OUT + 2 * I_G + I_D + I_PAD + I_ROPE;
        for (int it = gw; it < NITEMS; it += NGW) {
            int r = it;
            if (r < I_ADA) {
                const int kc = r / 48, cb = r % 48, n = cb * 256 + lane * 4;
                f32x4 a0 = {0, 0, 0, 0}, a1 = a0, a2 = a0;
#pragma unroll 8
                for (int kk = 0; kk < 64; ++kk) { const int k = kc * 64 + kk;
                    const f32x4 w = *(const f32x4*)(w_ada + (size_t)k * MODW + n);
                    const float c0 = cvec[k], c1 = cvec[DM + k], c2 = c_ctx[k];
                    a0 += w * (c0 * sigmoidf_(c0)); a1 += w * (c1 * sigmoidf_(c1)); a2 += w * (c2 * sigmoidf_(c2)); }
#pragma unroll
                for (int j = 0; j < 4; ++j) { atomicAdd(mod + n + j, a0[j]); atomicAdd(mod + MODW + n + j, a1[j]); atomicAdd(mod + 2 * MODW + n + j, a2[j]); }
                continue; } r -= I_ADA;
            if (r < I_IN) { const int kb = r / 250, nb = r % 250, n0 = nb * 32; p0_tr_item(w_in, DM, INW, kb * 64, n0, WinT, n0 + (n0 >= 3904 ? 192 : 0), nullptr, scr, lane); continue; } r -= I_IN;
            if (r < I_UQ) { const int kb = r / 48, nb = r % 48; p0_tr_item(w_uq, 512, MQW, kb * 64, nb * 32, WuqT, nb * 32, mla_q_g, scr, lane); continue; } r -= I_UQ;
            if (r < I_UKV) { const int kb = r / 64, nb = r % 64; p0_tr_item(w_ukv, 256, KVW, kb * 64, nb * 32, WukvT, nb * 32, mla_kv_g, scr, lane); continue; } r -= I_UKV;
            if (r < I_O) { const int kb = r / 64, nb = r % 64; p0_tr_item(w_o_da, OW, DM, kb * 64, nb * 32, WodaT, nb * 32, nullptr, scr, lane); continue; } r -= I_O;
            if (r < I_O) { const int kb = r / 64, nb = r % 64; p0_tr_item(w_o_mla, OW, DM, kb * 64, nb * 32, WomlaT, nb * 32, nullptr, scr, lane); continue; } r -= I_O;
            if (r < I_OUT) { const int kb = r / 64, nb = r % 64; p0_tr_item(w_out, DM, DM, kb * 64, nb * 32, WoutT, nb * 32, nullptr, scr, lane); continue; } r -= I_OUT;
            if (r < I_G) { const int kb = r / 176, nb = r % 176, n0 = nb * 32; p0_tr_item(w_gate, DM, FF, kb * 64, n0, WguT, (n0 >> 7) * 256 + (n0 & 127), nullptr, scr, lane); continue; } r -= I_G;
            if (r < I_G) { const int kb = r / 176, nb = r % 176, n0 = nb * 32; p0_tr_item(w_up, DM, FF, kb * 64, n0, WguT, (n0 >> 7) * 256 + 128 + (n0 & 127), nullptr, scr, lane); continue; } r -= I_G;
            if (r < I_D) { const int kb = r / 64, nb = r % 64; p0_tr_item(w_down, FF, DM, kb * 64, nb * 32, WdT, nb * 32, nullptr, scr, lane); continue; } r -= I_D;
            if (r < I_PAD) { u32x4* p = (u32x4*)(WinT + (size_t)(3904 + r) * DM) + lane; const u32x4 z = {0, 0, 0, 0};
#pragma unroll
                for (int j = 0; j < 4; ++j) p[64 * j] = z; continue; } r -= I_PAD;
            { const int e = r * 64 + lane, pos = e >> 4, i = e & 15;
              const float inv = exp2f(-(float)i * (13.287712379549449f / 16.0f)); const float a = (float)pos * inv;
              rope[e] = (f32x2){cosf(a), sinf(a)}; }
        }
    }
    SEAM(0);
    if (IN(1)) REP(1) {
        for (int r = gw; r < MR; r += NGW) {
            const int b = r / ROWS_B, rr = r % ROWS_B;
            const float* src = (rr < CTX) ? ctx + ((size_t)b * CTX + rr) * DM : xin + ((size_t)b * SEQ + (rr - CTX)) * DM;
            const int s = (rr < CTX) ? 2 : b;
            norm_row<0>(src, norm1_g, mod + s * MODW, b_ada, 0, DM, HB + (size_t)r * DM, lane);
        }
    }
    SEAM(1);
    if (IN(2)) REP(2) {
        { const u32x4* src = (const u32x4*)rope; LAS u32x4* dst = (LAS u32x4*)(lds + LDS_ROPE);
          dst[tid] = src[tid]; dst[tid + 512] = src[tid + 512]; __syncthreads(); }
        pg8::Gemm g{HB, WinT, DM, DM}; pg8::StaticOrder S; S.init(MR, ZW, G, bx, 0);
        pg8::EpiIn E{Z, (const LAS f32x2*)(lds + LDS_ROPE), rstd_q, rstd_kv};
        pg8::gemm_phase(lds, g, S, E);
    }
    SEAM(2);
    if (IN(4)) REP(4) {
        { const u32x4* src = (const u32x4*)rope; LAS u32x4* dst = (LAS u32x4*)(lds + LDS_ROPE);
          dst[tid] = src[tid]; dst[tid + 512] = src[tid + 512]; __syncthreads(); }
        { pg8::Gemm g{Z + Z_CQ, WuqT, ZW, 512}; pg8::StaticOrder S; S.init(ML, MQW, G, bx, 1);
          pg8::EpiMq E{MQ, (const LAS f32x2*)(lds + LDS_ROPE), rstd_q}; pg8::gemm_phase(lds, g, S, E); }
        { pg8::Gemm g{Z + Z_CKV, WukvT, ZW, 256}; pg8::StaticOrder S; S.init(MR, KVW, G, (bx + 128) % G, 0);
          pg8::EpiKv E{KV, rstd_kv}; pg8::gemm_phase(lds, g, S, E); }
    }
    SEAM(4);
    if (IN(5)) {
        const int r32 = lane & 31, hh = lane >> 5;
        float lam;
        { const float a = da_lambda[lane] * da_lambda[64 + lane], b2 = da_lambda[128 + lane] * da_lambda[192 + lane];
          lam = __expf(wave_sum(a)) - __expf(wave_sum(b2)) + LAM_INIT; }
        const int vcu = (G % 8 == 0) ? (bx & 7) * (G >> 3) + (bx >> 3) : bx;
#ifndef ATT_SKIP_DA
        for (int w = vcu; w < 256; w += G)
        for (int slot = 0; slot < 2; ++slot) REP(50) {
            const int pr = (w >> 5) * 2 + slot, qt = w & 31, b = pr >> 3, h = pr & 7;
            const int rowq = b * ROWS_B + CTX + qt * 256 + wave * 32;
            const bf16_t* Zb = Z + (size_t)b * ROWS_B * ZW;
            f32x16 o[4];
            float* st = stash + ((size_t)(bx * NWAVES + wave) * 64) * 64 + lane * 4;
            for (int sub = 0; sub < 2; ++sub) {
                const int sh_ = 2 * h + sub;
                att::attn_pass<false, ZW, ZW, ZW, ATT_TWO_DA>((LAS char*)lds, Z + (size_t)(rowq + r32) * ZW + Z_DQ + sh_ * 64 + hh * 8, nullptr,
                                      Zb + Z_DK + sh_ * 64, Zb + Z_DV + h * 128, o);
                if (sub == 0) {
                    f32x4* stp = (f32x4*)st; asm volatile("" : "+v"(stp));
#pragma unroll
                    for (int d = 0; d < 4; ++d)
#pragma unroll
                        for (int r = 0; r < 16; r += 4) stp[(d * 4 + (r >> 2)) * 64] = (f32x4){o[d][r], o[d][r + 1], o[d][r + 2], o[d][r + 3]};
                }
            }
            float ss[16];
#pragma unroll
            for (int r = 0; r < 16; ++r) ss[r] = 0.f;
#pragma unroll
            for (int d = 0; d < 4; ++d) {
                const f32x4* stp = (const f32x4*)st + d * 256; asm volatile("" : "+v"(stp));
#pragma unroll
                for (int r = 0; r < 16; r += 4) { const f32x4 sv = stp[(r >> 2) * 64];
#pragma unroll
                    for (int q = 0; q < 4; ++q) { const float v = sv[q] - lam * o[d][r + q]; o[d][r + q] = v; ss[r + q] += v * v; } } }
#pragma unroll
            for (int r = 0; r < 16; ++r) {
                float s = ss[r];
                s += __shfl_xor(s, 1); s += __shfl_xor(s, 2); s += __shfl_xor(s, 4); s += __shfl_xor(s, 8); s += __shfl_xor(s, 16);
                ss[r] = (1.0f - LAM_INIT) / sqrtf(s * (1.f / 128.f) + EPS);
            }
#pragma unroll
            for (int d = 0; d < 4; ++d) { const float gg = da_g[d * 32 + r32];
                bf16_t* zo = ODA + (size_t)(rowq + 4 * hh) * OW + h * 128 + d * 32 + r32; asm volatile("" : "+v"(zo));
#pragma unroll
                for (int r = 0; r < 16; ++r) {
                    const float v = o[d][r] * ss[r] * gg;
                    zo[(size_t)((r & 3) + 8 * (r >> 2)) * OW] = (bf16_t)(cvt_pk_bf16(v, v) & 0xffffu);
                } }
        }
#endif
#ifndef ATT_SKIP_MLA
        for (int w = vcu; w < 256; w += G)
        for (int slot = 0; slot < 2; ++slot) REP(51) {
            const int pr = (w >> 5) * 2 + slot, qt = w & 31, b = pr >> 3, h = pr & 7;
            const int rowq = b * ROWS_B + CTX + qt * 256 + wave * 32;
            const bf16_t* Zb = Z + (size_t)b * ROWS_B * ZW;
            f32x16 o[4];
            att::attn_pass<true, KVW, ZW, KVW, ATT_TWO_MLA>((LAS char*)lds, MQ + (size_t)(rowq + r32) * MQW + h * 192 + hh * 8,
                                 KV + (size_t)b * ROWS_B * KVW + h * 256, Zb + Z_KR, KV + (size_t)b * ROWS_B * KVW + h * 256 + 128, o);
#pragma unroll
            for (int d = 0; d < 4; ++d) {
                bf16_t* oo = OMLA + (size_t)(rowq + 4 * hh) * OW + h * 128 + d * 32 + r32; asm volatile("" : "+v"(oo));
#pragma unroll
                for (int r = 0; r < 16; ++r)
                    oo[(size_t)((r & 3) + 8 * (r >> 2)) * OW] = (bf16_t)(cvt_pk_bf16(o[d][r], o[d][r]) & 0xffffu); }
        }
#endif
    }
    SEAM(5);
    if (IN(6)) REP(6) {
        { pg8::Gemm g{ODA, WodaT, OW, OW}; pg8::StaticOrder S; S.init(ML, DM, G, bx, 1);
          pg8::EpiMerge<false> E{Y, Z + Z_GA}; pg8::gemm_phase(lds, g, S, E); }
        { pg8::Gemm g{OMLA, WomlaT, OW, OW}; pg8::StaticOrder S; S.init(ML, DM, G, bx, 1);
          pg8::EpiMerge<true> E{Y, Z + Z_GB}; pg8::gemm_phase(lds, g, S, E); }
    }
    SEAM(6);
    if (IN(7)) REP(7) {
        pg8::Gemm g{Y, WoutT, DM, DM}; pg8::StaticOrder S; S.init(ML, DM, G, bx, 1);
        pg8::EpiRes E{xin, out, mod, b_ada, 2 * DM}; pg8::gemm_phase(lds, g, S, E);
    }
    SEAM(7);
    if (IN(8)) REP(8) {
        for (int l = gw; l < ML; l += NGW) {
            const int b = l >> 13, r = l + 256 * (1 + b);
            norm_row<0>(out + (size_t)l * DM, norm2_g, mod + b * MODW, b_ada, 3 * DM, 4 * DM, H2 + (size_t)r * DM, lane);
        }
    }
    SEAM(8);
    if (IN(9)) REP(9) {
        pg8::Gemm g{H2, WguT, DM, DM}; pg8::StaticOrder S; S.init(ML, 2 * FF, G, bx, 1);
        pg8::EpiSwiglu E{ACT}; pg8::gemm_phase(lds, g, S, E);
    }
    SEAM(9);
    if (IN(10)) {
        pg8::Gemm g{ACT, WdT, FF, FF}; pg8::StaticOrder S; S.init(ML, DM, G, bx, 1);
        pg8::EpiRes E{out, out, mod, b_ada, 5 * DM}; pg8::gemm_phase(lds, g, S, E);
    }
    SEAM(10);
    if (IN(11)) {
        for (int l = gw; l < ML; l += NGW) norm_row<1>(out + (size_t)l * DM, final_g, nullptr, nullptr, 0, 0, out + (size_t)l * DM, lane);
    }
#if PROBE_DUP == 99
    if (lo == 0 && hi == N_PHASES_K) { for (int i = 0; i < 10; ++i) xcd_barrier(xbar); }
#endif
#undef IN
#undef SEAM
}

#undef ws
#undef xin
#undef cvec
#undef ctx
#undef c_ctx
#undef w_ada
#undef b_ada
#undef norm1_g
#undef norm2_g
#undef w_in
#undef da_lambda
#undef da_g
#undef mla_q_g
#undef mla_kv_g
#undef w_uq
#undef w_ukv
#undef w_o_da
#undef w_o_mla
#undef w_out
#undef w_gate
#undef w_up
#undef w_down
#undef final_g
#undef out
#undef mod
#undef rope
#undef rstd_q
#undef rstd_kv
#undef WinT
#undef WuqT
#undef WukvT
#undef WodaT
#undef WomlaT
#undef WoutT
#undef WguT
#undef WdT
#undef HB
#undef Z
#undef MQ
#undef KV
#undef Y
#undef H2
#undef ACT
#undef stash
#undef OMLA
#undef ODA
constexpr int N_PHASES = 12;

extern "C" void kernel_launch(void* const* d_in, const int* in_sizes, int n_in, void* d_out, int out_size, void* d_ws, size_t ws_size, hipStream_t stream) {
    static int grid = 0;
    if (grid == 0) {
        if (n_in != 22 || out_size != ML * DM || ws_size < WS_END) { fprintf(stderr, "kernel_launch: unexpected shapes (n_in %d out %d ws %zu)\n", n_in, out_size, ws_size); grid = -1; return; }
        int dev = 0, cus = 0, per_cu = 0;
        hipGetDevice(&dev); hipDeviceGetAttribute(&cus, hipDeviceAttributeMultiprocessorCount, dev);
        if (hipFuncSetAttribute((const void*)mk_fwd, hipFuncAttributeMaxDynamicSharedMemorySize, LDS_BYTES) != hipSuccess) { fprintf(stderr, "kernel_launch: hipFuncSetAttribute failed\n"); grid = -1; return; }
        if (hipOccupancyMaxActiveBlocksPerMultiprocessor(&per_cu, (const void*)mk_fwd, NWAVES * 64, LDS_BYTES) != hipSuccess || per_cu < 1) { fprintf(stderr, "kernel_launch: occupancy query says %d\n", per_cu); per_cu = 1; }
        (void)hipGetLastError();
        grid = cus;
        if (grid > 256) grid = 256;
    }
    if (grid < 0) return;
    (void)hipMemsetAsync((char*)d_ws + WS_MOD, 0, CTL_ZERO_BYTES, stream);
    Args a{};
    for (int i = 0; i < 22; ++i) a.in[i] = (const float*)d_in[i];
    a.out = (float*)d_out; a.ws = (unsigned char*)d_ws;
#if MK_PER_PHASE
    for (int p = 0; p < N_PHASES; ++p) { a.ph_lo = p; a.ph_hi = p + 1; hipLaunchKernelGGL(mk_fwd, dim3(grid), dim3(NWAVES * 64), LDS_BYTES, stream, a); }
#else
    a.ph_lo = 0; a.ph_hi = N_PHASES;
    void* kargs[] = {&a};
    hipError_t e = hipLaunchCooperativeKernel((const void*)mk_fwd, dim3(grid), dim3(NWAVES * 64), kargs, LDS_BYTES, stream);
    if (e != hipSuccess) fprintf(stderr, "cooperative launch failed: %s (grid %d)\n", hipGetErrorString(e), grid);
#endif
}
```

```cpp
#include <hip/hip_runtime.h>
#include <hip/hip_cooperative_groups.h>
#include <cstdio>
#include <cstdint>
namespace cg = cooperative_groups;

#define LAS __attribute__((address_space(3)))
typedef unsigned short bf16_t;
typedef short bf16x8 __attribute__((ext_vector_type(8)));
typedef short s16x4 __attribute__((ext_vector_type(4)));
typedef float f32x2 __attribute__((ext_vector_type(2)));
typedef float f32x4 __attribute__((ext_vector_type(4)));
typedef float f32x16 __attribute__((ext_vector_type(16)));
typedef unsigned u32x2 __attribute__((ext_vector_type(2)));
typedef unsigned u32x4 __attribute__((ext_vector_type(4)));

#ifndef ATT_TWO_DA
#define ATT_TWO_DA false
#endif
#ifndef ATT_TWO_MLA
#define ATT_TWO_MLA false
#endif
#ifndef MK_PER_PHASE
#define MK_PER_PHASE 0
#endif

constexpr int DM = 2048, NB = 2, SEQ = 8192, CTX = 256;
constexpr int ROWS_B = SEQ + CTX;
constexpr int MR = NB * ROWS_B;
constexpr int ML = NB * SEQ;
constexpr int ZW = 8192;
constexpr int Z_DQ = 0, Z_DK = 1024, Z_DV = 2048, Z_CQ = 3072, Z_CKV = 3584, Z_KR = 3840, Z_GA = 4096, Z_GB = 6144;
constexpr int FF = 5632, INW = 8000, MODW = 6 * DM;
constexpr int MQW = 1536, KVW = 2048, OW = 1024;
constexpr float EPS = 1e-6f;
constexpr float LOG2E = 1.4426950408889634f;
constexpr float C_DA = 0.125f * LOG2E;
constexpr float C_MLA = 0.07216878364870322f * LOG2E;
constexpr float LAM_INIT = 0.2f;

constexpr size_t MiB = 1u << 20;
constexpr size_t WS_MOD = 0;
constexpr size_t MOD_BYTES = 3 * MODW * 4;
constexpr size_t WS_BAR = 160 * 1024;
constexpr size_t WS_RSQ = 176 * 1024;
constexpr size_t WS_RSKV = 244 * 1024;
constexpr size_t CTL_ZERO_BYTES = 312 * 1024;
constexpr size_t WS_ROPE = 768 * 1024;
constexpr size_t WS_WIN = 1 * MiB;
constexpr size_t WS_WUQ = 33 * MiB;
constexpr size_t WS_WUKV = 35 * MiB;
constexpr size_t WS_WODA = 36 * MiB;
constexpr size_t WS_WOMLA = 40 * MiB;
constexpr size_t WS_WOUT = 44 * MiB;
constexpr size_t WS_WGU = 52 * MiB;
constexpr size_t WS_WD = 96 * MiB;
constexpr size_t WS_H = 118 * MiB;
constexpr size_t WS_Z = 184 * MiB;
constexpr size_t WS_MQ = 448 * MiB;
constexpr size_t WS_END = 498 * MiB;
constexpr size_t OUT_STASH = 0;
constexpr size_t OUT_OMLA = 32 * MiB;
constexpr size_t OUT_ODA = 66 * MiB;

constexpr int NWAVES = 8;
constexpr int LDS_ROPE = 131072;
constexpr int LDS_MISC = 154 * 1024;
constexpr int LDS_BYTES = 154 * 1024 + 256;

__device__ __forceinline__ unsigned cvt_pk_bf16(float lo, float hi) { unsigned r; asm volatile("v_cvt_pk_bf16_f32 %0, %1, %2" : "=v"(r) : "v"(lo), "v"(hi)); return r; }
__device__ __forceinline__ float bf_lo(unsigned w) { return __uint_as_float(w << 16); }
__device__ __forceinline__ float bf_hi(unsigned w) { return __uint_as_float(w & 0xffff0000u); }
__device__ __forceinline__ float wave_sum(float v) {
#pragma unroll
    for (int o = 1; o < 64; o <<= 1) v += __shfl_xor(v, o);
    return v;
}
__device__ __forceinline__ float sigmoidf_(float x) { return __builtin_amdgcn_rcpf(1.0f + __expf(-x)); }
__device__ __forceinline__ int r_to_l(int r) { return r - 256 * (1 + (r >= ROWS_B ? 1 : 0)); }

namespace pg8 {
constexpr int BM = 256, BK = 64, HALF = 128, HTB = HALF * BK * 2, STAGE_BYTES = 8 * HTB, NXCD = 8, WGM = 8;
__host__ __device__ __forceinline__ int lds_byte(int r, int c) { const int st = (r >> 4) * 2 + (c >> 5), rr = r & 15, cc = c & 31, ob = rr * 64 + cc * 2; return st * 1024 + (ob ^ (((ob >> 9) & 1) << 5)); }
__host__ __device__ __forceinline__ void stage_rc(int b, int& R, int& C) { const int st = b / 1024, sb = b % 1024, swz = sb ^ (((sb >> 9) & 1) << 5); R = (st >> 1) * 16 + swz / 64; C = (st & 1) * 32 + (swz % 64) / 2; }
__host__ __device__ __forceinline__ int perm32(int rho) { const int n = rho >> 4, i = rho & 15; return 8 * (i >> 2) + 4 * n + (i & 3); }

struct Unit { int pm, pn; };
struct Gemm { const bf16_t* A; const bf16_t* Bt; int lda; int K; };

struct StaticOrder {
    int nM, nN, nwg, G, c, latent;
    __device__ void init(int M, int N, int G_, int c_, int latent_) { nM = M / BM; nN = N / BM; nwg = nM * nN; G = G_; c = c_; latent = latent_; }
    __device__ bool next(int i, Unit& u) const {
        const long L = (long)i * G + c; if (L >= nwg) return false;
        int wgid = (int)L; { const int q = nwg / NXCD, r = nwg % NXCD, xcd = wgid % NXCD, off = wgid / NXCD; wgid = (xcd < r ? xcd * (q + 1) : r * (q + 1) + (xcd - r) * q) + off; }
        const int nig = WGM * nN, gid = wgid / nig, fm = gid * WGM, gsz = (nM - fm) < WGM ? (nM - fm) : WGM;
        u.pm = fm + ((wgid % nig) % gsz); u.pn = (wgid % nig) / gsz;
        if (latent) u.pm += 1 + (u.pm >= 32 ? 1 : 0);
        return true;
    }
};

template <class Epi>
__device__ __forceinline__ void gemm_phase(LAS unsigned char* lds, const Gemm g, const StaticOrder& S, const Epi& E) {
    int tid_ = threadIdx.x; asm volatile("" : "+v"(tid_));
    const int tid = tid_, wid = __builtin_amdgcn_readfirstlane(tid >> 6), lane = tid & 63, wr = wid >> 2, wc = wid & 3, fr = lane & 15, fq = lane >> 4;
    const int K = g.K, nt = K / BK, lda = g.lda;
    unsigned voffA[2], voffB[2];
#pragma unroll
    for (int i = 0; i < 2; ++i) { int R, C; stage_rc(tid * 16 + i * 8192, R, C); const int Rb = Epi::PERM ? ((R & ~31) + perm32(R & 31)) : R;
        voffA[i] = (unsigned)(R * lda + C) * 2u; voffB[i] = (unsigned)(Rb * K + C) * 2u; }
    const size_t kstep = (size_t)(BK * 2);
    const size_t hstepA = (size_t)HALF * lda * 2, hstepB = (size_t)HALF * K * 2;
    const size_t tstepA = 2 * hstepA, tstepB = 2 * hstepB;
    const unsigned ldsw = (unsigned)wid * 1024u;
    const int aoff = lds_byte(wr * 64 + fr, fq * 8), boff = lds_byte(wc * 32 + fr, fq * 8);
#define PG8_SA(b, h) (((b) * 2 + (h)) * HTB)
#define PG8_SB(b, h) ((4 + (b) * 2 + (h)) * HTB)
#define PG8_STAGE(bufoff, gbase, voff) do { _Pragma("unroll") for (int _i = 0; _i < 2; ++_i) \
        __builtin_amdgcn_global_load_lds((const unsigned*)((const char*)(gbase) + (voff)[_i]), (LAS unsigned*)(lds + (bufoff) + ldsw + _i * 8192), 16, 0, 0); } while (0)
#define PG8_LDA(dst, b, h) do { _Pragma("unroll") for (int m = 0; m < 4; ++m) _Pragma("unroll") for (int k = 0; k < 2; ++k) dst[m][k] = *(const LAS bf16x8*)(lds + PG8_SA(b, h) + aoff + m * 2048 + k * 1024); } while (0)
#define PG8_LDB(dst, b, h) do { _Pragma("unroll") for (int n = 0; n < 2; ++n) _Pragma("unroll") for (int k = 0; k < 2; ++k) dst[n][k] = *(const LAS bf16x8*)(lds + PG8_SB(b, h) + boff + n * 2048 + k * 1024); } while (0)
#define PG8_MMA(ai, bj, At, Bt) do { __builtin_amdgcn_s_setprio(1); _Pragma("unroll") for (int m = 0; m < 4; ++m) _Pragma("unroll") for (int n = 0; n < 2; ++n) _Pragma("unroll") for (int k = 0; k < 2; ++k) \
        acc[ai][bj][m][n] = __builtin_amdgcn_mfma_f32_16x16x32_bf16(Bt[n][k], At[m][k], acc[ai][bj][m][n], 0, 0, 0); __builtin_amdgcn_s_setprio(0); } while (0)
#define PG8_WAIT_V(n) asm volatile("s_waitcnt vmcnt(" #n ")" ::: "memory")
#define PG8_WAIT_L(n) asm volatile("s_waitcnt lgkmcnt(" #n ")" ::: "memory")
#define PG8_BAR __builtin_amdgcn_s_barrier()
#define PG8_SCHED __builtin_amdgcn_sched_barrier(0)
    Unit cur, nxt; int ui = 0;
    if (!S.next(0, cur)) return;
    f32x4 acc[2][2][4][2];
#pragma unroll
    for (int a = 0; a < 2; ++a)
#pragma unroll
        for (int b = 0; b < 2; ++b)
#pragma unroll
            for (int m = 0; m < 4; ++m)
#pragma unroll
                for (int n = 0; n < 2; ++n) acc[a][b][m][n] = (f32x4){0.f, 0.f, 0.f, 0.f};
    bf16x8 At[4][2], B0[2][2], B1[2][2];
    const char* cA = (const char*)g.A + (size_t)cur.pm * tstepA; const char* cB = (const char*)g.Bt + (size_t)cur.pn * tstepB;
    PG8_STAGE(PG8_SB(0, 0), cB, voffB); PG8_STAGE(PG8_SB(0, 1), cB + hstepB, voffB); PG8_STAGE(PG8_SA(0, 0), cA, voffA); PG8_STAGE(PG8_SA(0, 1), cA + hstepA, voffA);
    if (wr == 1) PG8_BAR;
    PG8_WAIT_V(2); PG8_BAR;
    PG8_STAGE(PG8_SB(1, 0), cB + kstep, voffB); PG8_STAGE(PG8_SA(1, 0), cA + kstep, voffA); PG8_STAGE(PG8_SB(1, 1), cB + hstepB + kstep, voffB);
    PG8_WAIT_V(6); PG8_BAR;
    for (;;) {
        const bool has_next = S.next(ui + 1, nxt);
        const char* nA = has_next ? (const char*)g.A + (size_t)nxt.pm * tstepA : cA; const char* nB = has_next ? (const char*)g.Bt + (size_t)nxt.pn * tstepB : cB;
        for (int t = 0; t < nt; t += 2) {
            const bool last = (t == nt - 2);
            const char* a1 = cA + (size_t)(t + 1) * kstep;
            const char* a2 = last ? nA : cA + (size_t)(t + 2) * kstep; const char* b2 = last ? nB : cB + (size_t)(t + 2) * kstep;
            const char* a3 = a2 + kstep; const char* b3 = b2 + kstep;
            PG8_LDB(B0, 0, 0); PG8_LDB(B1, 0, 1); PG8_SCHED; PG8_LDA(At, 0, 0); PG8_STAGE(PG8_SA(1, 1), a1 + hstepA, voffA);
            PG8_WAIT_V(8); PG8_WAIT_L(0); PG8_BAR; PG8_MMA(0, 0, At, B0); PG8_MMA(0, 1, At, B1); PG8_BAR; PG8_SCHED;
            PG8_LDA(At, 0, 1); PG8_STAGE(PG8_SB(0, 0), b2, voffB); PG8_STAGE(PG8_SB(0, 1), b2 + hstepB, voffB); PG8_STAGE(PG8_SA(0, 0), a2, voffA);
            PG8_WAIT_V(8); PG8_WAIT_L(0); PG8_BAR; PG8_MMA(1, 0, At, B0); PG8_MMA(1, 1, At, B1); PG8_BAR; PG8_SCHED;
            PG8_LDB(B0, 1, 0); PG8_LDB(B1, 1, 1); PG8_SCHED; PG8_LDA(At, 1, 0); PG8_STAGE(PG8_SA(0, 1), a2 + hstepA, voffA);
            PG8_WAIT_V(8); PG8_WAIT_L(0); PG8_BAR; PG8_MMA(0, 0, At, B0); PG8_MMA(0, 1, At, B1); PG8_BAR; PG8_SCHED;
            PG8_LDA(At, 1, 1); PG8_STAGE(PG8_SB(1, 0), b3, voffB); PG8_STAGE(PG8_SB(1, 1), b3 + hstepB, voffB); PG8_STAGE(PG8_SA(1, 0), a3, voffA);
            PG8_WAIT_V(8); PG8_WAIT_L(0); PG8_BAR; PG8_MMA(1, 0, At, B0); PG8_MMA(1, 1, At, B1); PG8_BAR; PG8_SCHED;
        }
        if (wr == 0) PG8_BAR;
        E(acc, cur, wr, wc, fr, fq);
        if (!has_next) break;
#pragma unroll
        for (int a = 0; a < 2; ++a)
#pragma unroll
            for (int b = 0; b < 2; ++b)
#pragma unroll
                for (int m = 0; m < 4; ++m)
#pragma unroll
                    for (int n = 0; n < 2; ++n) acc[a][b][m][n] = (f32x4){0.f, 0.f, 0.f, 0.f};
        cur = nxt; cA = nA; cB = nB; ++ui;
        if (wr == 1) PG8_BAR;
    }
    PG8_WAIT_V(0);
    PG8_BAR;
#undef PG8_SA
#undef PG8_SB
#undef PG8_STAGE
#undef PG8_LDA
#undef PG8_LDB
#undef PG8_MMA
#undef PG8_WAIT_V
#undef PG8_WAIT_L
#undef PG8_BAR
#undef PG8_SCHED
}

typedef f32x4 Acc[2][2][4][2];

__device__ __forceinline__ void store8(bf16_t* p, f32x4 v0, f32x4 v1) {
    u32x4 w; w.x = cvt_pk_bf16(v0[0], v0[1]); w.y = cvt_pk_bf16(v0[2], v0[3]); w.z = cvt_pk_bf16(v1[0], v1[1]); w.w = cvt_pk_bf16(v1[2], v1[3]);
    *(u32x4*)p = w;
}
__device__ __forceinline__ void rope8(f32x4& v0, f32x4& v1, const LAS f32x2* tab  , int fq) {
    const f32x4 t0 = *(const LAS f32x4*)(tab), t1 = *(const LAS f32x4*)(tab + 2), t2 = *(const LAS f32x4*)(tab + 4), t3 = *(const LAS f32x4*)(tab + 6);
    const float cs[8] = {t0[0], t0[2], t1[0], t1[2], t2[0], t2[2], t3[0], t3[2]};
    const float sn[8] = {t0[1], t0[3], t1[1], t1[3], t2[1], t2[3], t3[1], t3[3]};
    const float sg = (fq < 2) ? -1.f : 1.f;
#pragma unroll
    for (int j = 0; j < 4; ++j) { const float p = __shfl_xor(v0[j], 32); v0[j] = v0[j] * cs[j] + sg * p * sn[j]; }
#pragma unroll
    for (int j = 0; j < 4; ++j) { const float p = __shfl_xor(v1[j], 32); v1[j] = v1[j] * cs[4 + j] + sg * p * sn[4 + j]; }
}

struct EpiIn {
    static constexpr bool PERM = true;
    bf16_t* Z; const LAS f32x2* rope; float* ssq_q; float* ssq_kv;
    __device__ __forceinline__ void operator()(const Acc& acc, const Unit& u, int wr, int wc, int fr, int fq) const {
        const int pn = u.pn, pmb = u.pm % 33;
        const bool ropetile = (pn < 8) || (pn == 15);
        const bool dorope = ropetile && (pmb != 0);
        const bool statt = (pn >= 12 && pn <= 14);
        const float sc = (pn < 4) ? C_DA : 1.f;
        const int t0 = (pmb - 1) * 256;
        const int row0 = u.pm * BM + wr * 64 + fr, col0 = pn * BM + wc * 32 + 8 * fq;
#pragma unroll
        for (int ai = 0; ai < 2; ++ai)
#pragma unroll
            for (int m = 0; m < 4; ++m) {
                const int pos = (wc & 1) ? (16 * m + fr) : ((t0 >> 6) + 2 * ai + wr);
                const LAS f32x2* tab = rope + pos * 16 + 8 * (fq & 1);
                bf16_t* rowp = Z + (size_t)(row0 + ai * HALF + m * 16) * ZW + col0;
                float sq = 0.f;
#pragma unroll
                for (int bj = 0; bj < 2; ++bj) {
                    f32x4 v0 = acc[ai][bj][m][0], v1 = acc[ai][bj][m][1];
                    if (dorope) rope8(v0, v1, tab, fq);
                    v0 = v0 * sc; v1 = v1 * sc;
                    if (statt) { const f32x4 q0 = v0 * v0, q1 = v1 * v1; sq += (q0[0] + q0[1]) + (q0[2] + q0[3]) + (q1[0] + q1[1]) + (q1[2] + q1[3]); }
                    store8(rowp + bj * HALF, v0, v1);
                }
                if (statt) { sq += __shfl_xor(sq, 16); sq += __shfl_xor(sq, 32);
                    if (fq == 0) atomicAdd((pn == 14 ? ssq_kv : ssq_q) + row0 + ai * HALF + m * 16, sq); }
            }
    }
};
struct EpiMq {
    static constexpr bool PERM = true;
    bf16_t* MQ; const LAS f32x2* rope; const float* rstd;
    __device__ __forceinline__ void operator()(const Acc& acc, const Unit& u, int wr, int wc, int fr, int fq) const {
        const int pn = u.pn, pmb = u.pm % 33;
        const int t0 = (pmb - 1) * 256;
        const int row0 = u.pm * BM + wr * 64 + fr, col0 = pn * BM + wc * 32 + 8 * fq;
#pragma unroll
        for (int ai = 0; ai < 2; ++ai) {
#pragma unroll
            for (int m = 0; m < 4; ++m) {
                const int row = row0 + ai * HALF + m * 16;
                const float rs = C_MLA / sqrtf(rstd[row] * (1.f / 512.f) + EPS);
                bf16_t* rowp = MQ + (size_t)row * MQW + col0;
#pragma unroll
                for (int bj = 0; bj < 2; ++bj) {
                    const int gm = (8 * pn + 4 * bj + wc) % 6;
                    f32x4 v0 = acc[ai][bj][m][0], v1 = acc[ai][bj][m][1];
                    if (gm >= 4) {
                        const int pos = (gm == 5) ? (16 * m + fr) : ((t0 >> 6) + 2 * ai + wr);
                        rope8(v0, v1, rope + pos * 16 + 8 * (fq & 1), fq);
                    }
                    v0 = v0 * rs; v1 = v1 * rs;
                    store8(rowp + bj * HALF, v0, v1);
                }
            }
            asm volatile("" ::: "memory");
        }
    }
};
struct EpiKv {
    static constexpr bool PERM = true;
    bf16_t* KV; const float* rstd;
    __device__ __forceinline__ void operator()(const Acc& acc, const Unit& u, int wr, int wc, int fr, int fq) const {
        const int row0 = u.pm * BM + wr * 64 + fr, col0 = u.pn * BM + wc * 32 + 8 * fq;
#pragma unroll
        for (int ai = 0; ai < 2; ++ai)
#pragma unroll
            for (int m = 0; m < 4; ++m) {
                const int row = row0 + ai * HALF + m * 16;
                const float rs = 1.0f / sqrtf(rstd[row] * (1.f / 256.f) + EPS);
                bf16_t* rowp = KV + (size_t)row * KVW + col0;
#pragma unroll
                for (int bj = 0; bj < 2; ++bj) store8(rowp + bj * HALF, acc[ai][bj][m][0] * rs, acc[ai][bj][m][1] * rs);
            }
    }
};
template <bool ADD> struct EpiMerge {
    static constexpr bool PERM = true;
    bf16_t* Y; const bf16_t* G;
    __device__ __forceinline__ void operator()(const Acc& acc, const Unit& u, int wr, int wc, int fr, int fq) const {
        const int row0 = u.pm * BM + wr * 64 + fr, col0 = u.pn * BM + wc * 32 + 8 * fq;
#pragma unroll
        for (int ai = 0; ai < 2; ++ai)
#pragma unroll
        for (int mh = 0; mh < 2; ++mh) {
            u32x4 gw[2][2], yw[2][2];
#pragma unroll
            for (int mm = 0; mm < 2; ++mm) { const int row = row0 + ai * HALF + (2 * mh + mm) * 16;
#pragma unroll
                for (int bj = 0; bj < 2; ++bj) { gw[mm][bj] = *(const u32x4*)(G + (size_t)row * ZW + col0 + bj * HALF);
                    if (ADD) yw[mm][bj] = *(const u32x4*)(Y + (size_t)row * DM + col0 + bj * HALF); } }
            asm volatile("" ::: "memory");
#pragma unroll
            for (int mm = 0; mm < 2; ++mm) { const int m = 2 * mh + mm; const int row = row0 + ai * HALF + m * 16;
                bf16_t* yp = Y + (size_t)row * DM + col0;
#pragma unroll
                for (int bj = 0; bj < 2; ++bj) {
                    const u32x4 g4 = gw[mm][bj];
                    f32x4 s0 = {sigmoidf_(bf_lo(g4.x)), sigmoidf_(bf_hi(g4.x)), sigmoidf_(bf_lo(g4.y)), sigmoidf_(bf_hi(g4.y))};
                    f32x4 s1 = {sigmoidf_(bf_lo(g4.z)), sigmoidf_(bf_hi(g4.z)), sigmoidf_(bf_lo(g4.w)), sigmoidf_(bf_hi(g4.w))};
                    f32x4 v0 = acc[ai][bj][m][0] * s0, v1 = acc[ai][bj][m][1] * s1;
                    if (ADD) { const u32x4 y4 = yw[mm][bj];
                        v0 += (f32x4){bf_lo(y4.x), bf_hi(y4.x), bf_lo(y4.y), bf_hi(y4.y)}; v1 += (f32x4){bf_lo(y4.z), bf_hi(y4.z), bf_lo(y4.w), bf_hi(y4.w)}; }
                    store8(yp + bj * HALF, v0, v1);
                } }
            asm volatile("" ::: "memory");
        }
    }
};
struct EpiRes {
    static constexpr bool PERM = false;
    const float* base; float* out; const float* mod; const float* bada; int goff;
    __device__ __forceinline__ void operator()(const Acc& acc, const Unit& u, int wr, int wc, int fr, int fq) const {
        const int row0 = u.pm * BM + wr * 64 + fr, col0 = u.pn * BM + wc * 32 + 4 * fq;
        const int b = (u.pm >= 33) ? 1 : 0;
        f32x4 gv[2][2];
#pragma unroll
        for (int bj = 0; bj < 2; ++bj)
#pragma unroll
            for (int n = 0; n < 2; ++n) gv[bj][n] = *(const f32x4*)(mod + b * MODW + goff + col0 + bj * HALF + 16 * n) + *(const f32x4*)(bada + goff + col0 + bj * HALF + 16 * n);
#pragma unroll
        for (int ai = 0; ai < 2; ++ai)
#pragma unroll
        for (int mh = 0; mh < 2; ++mh) {
            f32x4 bs[2][2][2];
#pragma unroll
            for (int mm = 0; mm < 2; ++mm) { const int m = 2 * mh + mm; const size_t off = (size_t)r_to_l(row0 + ai * HALF + m * 16) * DM + col0;
#pragma unroll
                for (int bj = 0; bj < 2; ++bj)
#pragma unroll
                    for (int n = 0; n < 2; ++n) bs[mm][bj][n] = *(const f32x4*)(base + off + bj * HALF + 16 * n); }
            asm volatile("" ::: "memory");
#pragma unroll
            for (int mm = 0; mm < 2; ++mm) { const int m = 2 * mh + mm; const size_t off = (size_t)r_to_l(row0 + ai * HALF + m * 16) * DM + col0;
#pragma unroll
                for (int bj = 0; bj < 2; ++bj)
#pragma unroll
                    for (int n = 0; n < 2; ++n) *(f32x4*)(out + off + bj * HALF + 16 * n) = bs[mm][bj][n] + gv[bj][n] * acc[ai][bj][m][n]; }
            asm volatile("" ::: "memory");
        }
    }
};
struct EpiSwiglu {
    static constexpr bool PERM = true;
    bf16_t* ACT;
    __device__ __forceinline__ void operator()(const Acc& acc, const Unit& u, int wr, int wc, int fr, int fq) const {
        const int row0 = u.pm * BM + wr * 64 + fr, col0 = u.pn * HALF + wc * 32 + 8 * fq;
#pragma unroll
        for (int ai = 0; ai < 2; ++ai)
#pragma unroll
            for (int m = 0; m < 4; ++m) {
                const int row = row0 + ai * HALF + m * 16;
                f32x4 o[2];
#pragma unroll
                for (int n = 0; n < 2; ++n) {
                    const f32x4 gt = acc[ai][0][m][n], up = acc[ai][1][m][n];
#pragma unroll
                    for (int j = 0; j < 4; ++j) o[n][j] = gt[j] * sigmoidf_(gt[j]) * up[j];
                }
                store8(ACT + (size_t)row * FF + col0, o[0], o[1]);
            }
    }
};
}

namespace att {
constexpr int NT = ROWS_B / 64;
constexpr int L_KN = 0, KN_B = 16384;
constexpr int L_KR = 32768, KR_B = 8192;
constexpr int L_V = 49152, V_B = 16384;
constexpr int L_WS = 98304;
constexpr int L_Q = 100352;
constexpr float THR = 8.f;
#define SBAR() __builtin_amdgcn_sched_barrier(0)
__device__ __forceinline__ int crow(int r, int hi) { return (r & 3) + 8 * (r >> 2) + 4 * hi; }

__device__ __forceinline__ void partialSM(f32x16& p0, f32x16& p1, float& m_reg, float& alpha) {
    float pmax = p0[0];
#pragma unroll
    for (int r = 1; r < 16; ++r) pmax = fmaxf(pmax, p0[r]);
#pragma unroll
    for (int r = 0; r < 16; ++r) pmax = fmaxf(pmax, p1[r]);
    { auto rr = __builtin_amdgcn_permlane32_swap(__float_as_uint(pmax), __float_as_uint(pmax), false, false);
      pmax = fmaxf(__uint_as_float(rr[0]), __uint_as_float(rr[1])); }
    float mn;
    if (__builtin_expect(__all(pmax - m_reg <= THR), 1)) { mn = m_reg; alpha = 1.f; }
    else { mn = fmaxf(m_reg, pmax); alpha = __builtin_amdgcn_exp2f(m_reg - mn); m_reg = mn; }
#pragma unroll
    for (int r = 0; r < 16; ++r) p0[r] = p0[r] - mn;
#pragma unroll
    for (int r = 0; r < 16; ++r) p1[r] = p1[r] - mn;
#pragma unroll
    for (int r = 0; r < 16; ++r) p0[r] = __builtin_amdgcn_exp2f(p0[r]);
}
__device__ __forceinline__ void partialSM_rel(f32x16& p0, f32x16& p1, float& m_reg, float& alpha, f32x16& negm) {
    float pmax = p0[0];
#pragma unroll
    for (int r = 1; r < 16; ++r) pmax = fmaxf(pmax, p0[r]);
#pragma unroll
    for (int r = 0; r < 16; ++r) pmax = fmaxf(pmax, p1[r]);
    { auto rr = __builtin_amdgcn_permlane32_swap(__float_as_uint(pmax), __float_as_uint(pmax), false, false);
      pmax = fmaxf(__uint_as_float(rr[0]), __uint_as_float(rr[1])); }
    if (__builtin_expect(__all(pmax <= THR), 1)) { alpha = 1.f; }
    else { const float dl = fmaxf(pmax, 0.f); m_reg += dl; alpha = __builtin_amdgcn_exp2f(-dl);
#pragma unroll
        for (int r = 0; r < 16; ++r) { p0[r] -= dl; p1[r] -= dl; }
        const float nm = -m_reg;
#pragma unroll
        for (int r = 0; r < 16; ++r) negm[r] = nm;
        asm volatile("" : "+v"(negm)); }
#pragma unroll
    for (int r = 0; r < 16; ++r) p0[r] = __builtin_amdgcn_exp2f(p0[r]);
}
__device__ __forceinline__ void finishSM(f32x16& p0, f32x16& p1, float alpha, float& l_reg, bf16x8& pa0, bf16x8& pa1, bf16x8& pa2, bf16x8& pa3) {
#pragma unroll
    for (int r = 0; r < 16; ++r) p1[r] = __builtin_amdgcn_exp2f(p1[r]);
    float ps = 0;
#pragma unroll
    for (int r = 0; r < 16; ++r) ps += p0[r];
#pragma unroll
    for (int r = 0; r < 16; ++r) ps += p1[r];
    { auto rr = __builtin_amdgcn_permlane32_swap(__float_as_uint(ps), __float_as_uint(ps), false, false);
      ps = __uint_as_float(rr[0]) + __uint_as_float(rr[1]); }
    l_reg = l_reg * alpha + ps;
#define PK4(P, BASE, OUT) do { unsigned a0 = cvt_pk_bf16(P[BASE + 0], P[BASE + 1]), a1 = cvt_pk_bf16(P[BASE + 2], P[BASE + 3]);   \
    unsigned b0 = cvt_pk_bf16(P[BASE + 4], P[BASE + 5]), b1 = cvt_pk_bf16(P[BASE + 6], P[BASE + 7]);                              \
    u32x4 w = {a0, a1, b0, b1}; OUT = __builtin_bit_cast(bf16x8, w); } while (0)
    PK4(p0, 0, pa0); PK4(p0, 8, pa1); PK4(p1, 0, pa2); PK4(p1, 8, pa3);
#undef PK4
}
template <bool NOPE>
__device__ __forceinline__ void qkt(f32x16& p0, f32x16& p1, const LAS char* Kn, const LAS char* Kr, const bf16x8* qr, const LAS char* qlds, int r32, int hi) {
    p0 = f32x16{}; p1 = f32x16{};
    if (NOPE) {
        const int x = r32 & 15;
#pragma unroll
        for (int d0 = 0; d0 < 8; ++d0) { const int ch = ((2 * d0 + hi) ^ x) << 4;
            const bf16x8 b0 = *(const LAS bf16x8*)(Kn + r32 * 256 + ch);
            const bf16x8 b1 = *(const LAS bf16x8*)(Kn + (32 + r32) * 256 + ch);
            bf16x8 q; if (d0 < 5) q = qr[d0]; else q = *(const LAS bf16x8*)(qlds + (d0 - 5) * 1024);
            p0 = __builtin_amdgcn_mfma_f32_32x32x16_bf16(b0, q, p0, 0, 0, 0);
            p1 = __builtin_amdgcn_mfma_f32_32x32x16_bf16(b1, q, p1, 0, 0, 0); }
    }
    const int f = (r32 >> 1) & 7;
#pragma unroll
    for (int d0 = 0; d0 < 4; ++d0) { const int ch = ((2 * d0 + hi) ^ f) << 4;
        const bf16x8 b0 = *(const LAS bf16x8*)(Kr + r32 * 128 + ch);
        const bf16x8 b1 = *(const LAS bf16x8*)(Kr + (32 + r32) * 128 + ch);
        bf16x8 q; if (NOPE) q = *(const LAS bf16x8*)(qlds + (3 + d0) * 1024); else q = qr[d0];
        p0 = __builtin_amdgcn_mfma_f32_32x32x16_bf16(b0, q, p0, 0, 0, 0);
        p1 = __builtin_amdgcn_mfma_f32_32x32x16_bf16(b1, q, p1, 0, 0, 0); }
}
template <bool NOPE>
__device__ __forceinline__ void qkt_pipe(f32x16& p0, f32x16& p1, const LAS char* Kn, const LAS char* Kr, const bf16x8* qr, const LAS char* qlds, int r32, int hi, const f32x16& negm) {
    constexpr int NC = NOPE ? 6 : 2;
    const int x = r32 & 15, f = (r32 >> 1) & 7;
    const LAS char* kn0 = Kn + r32 * 256; const LAS char* kr0 = Kr + r32 * 128;
    bf16x8 ka[4], kb[4], qa[2], qb[2];
#define LOADC(k, q, c) do { _Pragma("unroll") for (int i_ = 0; i_ < 2; ++i_) { const int d0 = 2 * (c) + i_; \
        if (NOPE && d0 < 8) { const int ch = ((2 * d0 + hi) ^ x) << 4; k[2 * i_] = *(const LAS bf16x8*)(kn0 + ch); k[2 * i_ + 1] = *(const LAS bf16x8*)(kn0 + 32 * 256 + ch); } \
        else { const int dr = d0 - (NOPE ? 8 : 0); const int ch = ((2 * dr + hi) ^ f) << 4; k[2 * i_] = *(const LAS bf16x8*)(kr0 + ch); k[2 * i_ + 1] = *(const LAS bf16x8*)(kr0 + 32 * 128 + ch); } \
        if (NOPE) { if (d0 < 5) q[i_] = qr[d0]; else q[i_] = *(const LAS bf16x8*)(qlds + (d0 - 5) * 1024); } else q[i_] = qr[d0]; } } while (0)
#define MMAC(k, q) do { _Pragma("unroll") for (int i_ = 0; i_ < 2; ++i_) { \
        p0 = __builtin_amdgcn_mfma_f32_32x32x16_bf16(k[2 * i_], q[i_], p0, 0, 0, 0); p1 = __builtin_amdgcn_mfma_f32_32x32x16_bf16(k[2 * i_ + 1], q[i_], p1, 0, 0, 0); } } while (0)
    LOADC(ka, qa, 0); LOADC(kb, qb, 1); SBAR();
    if (NOPE) { p0 = f32x16{}; p1 = f32x16{}; p0 = __builtin_amdgcn_mfma_f32_32x32x16_bf16(ka[0], qa[0], p0, 0, 0, 0); p1 = __builtin_amdgcn_mfma_f32_32x32x16_bf16(ka[1], qa[0], p1, 0, 0, 0); }
    else { p0 = __builtin_amdgcn_mfma_f32_32x32x16_bf16(ka[0], qa[0], negm, 0, 0, 0); p1 = __builtin_amdgcn_mfma_f32_32x32x16_bf16(ka[1], qa[0], negm, 0, 0, 0); }
    p0 = __builtin_amdgcn_mfma_f32_32x32x16_bf16(ka[2], qa[1], p0, 0, 0, 0); p1 = __builtin_amdgcn_mfma_f32_32x32x16_bf16(ka[3], qa[1], p1, 0, 0, 0); SBAR();
    if (NC > 2) {
        LOADC(ka, qa, 2); SBAR(); MMAC(kb, qb); SBAR();
        LOADC(kb, qb, 3); SBAR(); MMAC(ka, qa); SBAR();
        LOADC(ka, qa, 4); SBAR(); MMAC(kb, qb); SBAR();
        LOADC(kb, qb, 5); SBAR(); MMAC(ka, qa); SBAR();
        MMAC(kb, qb); SBAR();
    } else {
        MMAC(kb, qb); SBAR();
    }
#undef LOADC
#undef MMAC
}
__device__ __forceinline__ int v_st(int k, int c) { const int kk = (k & ~0xC) | ((k & 4) << 1) | ((k & 8) >> 1); return ((kk >> 3) * 4 + (c >> 5)) * 512 + ((kk & 7) * 32 + (c & 31)) * 2; }
__device__ __forceinline__ int v_rd_base(int lane) { return ((lane & 3) << 3) | (((lane >> 2) & 3) << 6) | (((lane >> 4) & 1) << 5) | (((lane >> 5) & 1) << 8); }
constexpr int v_rd_off(int d0, int ks, int half) { return d0 * 512 + ks * 4096 + half * 2048; }
template <int OFF> __device__ __forceinline__ s16x4 tr_read(int vb) {
    s16x4 r; asm volatile("ds_read_b64_tr_b16 %0, %1 offset:%2" : "=&v"(r) : "v"(vb), "i"(OFF) : "memory"); return r;
}
template <int D0> __device__ __forceinline__ void pv_one(f32x16& od, int vb, bf16x8 pa0, bf16x8 pa1, bf16x8 pa2, bf16x8 pa3) {
    const s16x4 l0 = tr_read<v_rd_off(D0, 0, 0)>(vb), h0 = tr_read<v_rd_off(D0, 0, 1)>(vb), l1 = tr_read<v_rd_off(D0, 1, 0)>(vb), h1 = tr_read<v_rd_off(D0, 1, 1)>(vb);
    const s16x4 l2 = tr_read<v_rd_off(D0, 2, 0)>(vb), h2 = tr_read<v_rd_off(D0, 2, 1)>(vb), l3 = tr_read<v_rd_off(D0, 3, 0)>(vb), h3 = tr_read<v_rd_off(D0, 3, 1)>(vb);
    asm volatile("s_waitcnt lgkmcnt(0)" ::: "memory"); SBAR();
#define PK(L, H) (bf16x8){L[0], L[1], L[2], L[3], H[0], H[1], H[2], H[3]}
    od = __builtin_amdgcn_mfma_f32_32x32x16_bf16(pa0, PK(l0, h0), od, 0, 0, 0);
    od = __builtin_amdgcn_mfma_f32_32x32x16_bf16(pa1, PK(l1, h1), od, 0, 0, 0);
    od = __builtin_amdgcn_mfma_f32_32x32x16_bf16(pa2, PK(l2, h2), od, 0, 0, 0);
    od = __builtin_amdgcn_mfma_f32_32x32x16_bf16(pa3, PK(l3, h3), od, 0, 0, 0);
#undef PK
}
__device__ __forceinline__ void pv_d0(f32x16* o, int vb, bf16x8 pa0, bf16x8 pa1, bf16x8 pa2, bf16x8 pa3) {
    pv_one<0>(o[0], vb, pa0, pa1, pa2, pa3); pv_one<1>(o[1], vb, pa0, pa1, pa2, pa3); pv_one<2>(o[2], vb, pa0, pa1, pa2, pa3); pv_one<3>(o[3], vb, pa0, pa1, pa2, pa3);
}

template <bool NOPE, int ldkn, int ldkr, int ldv, bool TWO>
__device__ __forceinline__ void attn_pass(LAS char* lds, const bf16_t* Qw, const bf16_t* Kn, const bf16_t* Kr, const bf16_t* V, f32x16 (&o)[4]) {
    int tid_ = threadIdx.x; asm volatile("" : "+v"(tid_));
    const int tid = tid_, lane = tid & 63, r32 = lane & 31, hi = lane >> 5; const int wid = __builtin_amdgcn_readfirstlane(tid >> 6);
    LAS float* ws = (LAS float*)(lds + L_WS) + wid * 64; LAS float* li_l = ws; LAS float* al_l = ws + 32;
    constexpr int NQ = NOPE ? 5 : 4;
    bf16x8 qr[NQ];
#pragma unroll
    for (int d0 = 0; d0 < NQ; ++d0) qr[d0] = *(const bf16x8*)(Qw + d0 * 16);
    const LAS char* qlds = lds + L_Q + wid * 7168 + lane * 16;
    if (NOPE) {
#pragma unroll
        for (int d0 = 0; d0 < 7; ++d0) *(LAS bf16x8*)(lds + L_Q + wid * 7168 + lane * 16 + d0 * 1024) = *(const bf16x8*)(Qw + (5 + d0) * 16);
    }
    unsigned okn0 = 0, okn1 = 0;
    if (NOPE) {
        { const int b = (wid * 2) * 1024 + lane * 16, row = b >> 8, ch = ((b & 255) >> 4) ^ (row & 15); okn0 = (unsigned)(row * ldkn + ch * 8) * 2u; }
        { const int b = (wid * 2 + 1) * 1024 + lane * 16, row = b >> 8, ch = ((b & 255) >> 4) ^ (row & 15); okn1 = (unsigned)(row * ldkn + ch * 8) * 2u; }
    }
    unsigned okr; { const int b = wid * 1024 + lane * 16, row = b >> 7, ch = ((b & 127) >> 4) ^ ((row >> 1) & 7); okr = (unsigned)(row * ldkr + ch * 8) * 2u; }
    unsigned ov0, ov1;
    { const int off = (wid * 2) * 1024 + lane * 16, sub = off >> 9, w = (off & 511) >> 1, kk = (sub >> 2) * 8 + (w >> 5), k = kk  , c = (sub & 3) * 32 + (w & 31);
      ov0 = (unsigned)(k * ldv + c) * 2u; }
    { const int off = (wid * 2 + 1) * 1024 + lane * 16, sub = off >> 9, w = (off & 511) >> 1, kk = (sub >> 2) * 8 + (w >> 5), k = kk  , c = (sub & 3) * 32 + (w & 31);
      ov1 = (unsigned)(k * ldv + c) * 2u; }
    const char* bkn = (const char*)Kn; const char* bkr = (const char*)Kr; const char* bv = (const char*)V;
    const size_t kn_step = (size_t)64 * ldkn * 2, kr_step = (size_t)64 * ldkr * 2, v_step = (size_t)64 * ldv * 2;
    const unsigned wo1 = (unsigned)wid * 1024u, wo2 = (unsigned)wid * 2048u;
#define GLDS(src, dstoff) __builtin_amdgcn_global_load_lds((const unsigned*)(src), (LAS unsigned*)(lds + (dstoff)), 16, 0, 0)
#define DMA_TILE(kb, vslot) do { \
    if (NOPE) { GLDS(bkn + okn0, L_KN + (kb) * KN_B + wo2); GLDS(bkn + okn1, L_KN + (kb) * KN_B + wo2 + 1024u); bkn += kn_step; } \
    GLDS(bkr + okr, L_KR + (kb) * KR_B + wo1); bkr += kr_step; \
    GLDS(bv + ov0, L_V + (vslot) + wo2); GLDS(bv + ov1, L_V + (vslot) + wo2 + 1024u); bv += v_step; } while (0)
    constexpr int PF_AHEAD = 3;
    const char* pfp = nullptr;
    if (!NOPE) { const int li = tid % 192; pfp = (li < 64) ? (const char*)(Kr + (size_t)li * ldkr) : (const char*)(V + (size_t)((li - 64) >> 1) * ldv + ((li - 64) & 1) * 64);
                 pfp += (size_t)PF_AHEAD * kr_step; }
    int pft = PF_AHEAD;
#define PREFETCH() do { if (!NOPE) { const char* p_ = (pft < NT) ? pfp : pfp - (size_t)PF_AHEAD * kr_step; __builtin_amdgcn_global_load_lds((const unsigned*)p_, (LAS unsigned*)(lds + L_Q + wid * 256), 4, 0, 0); pfp += kr_step; ++pft; } } while (0)
#define WAITSYNC() do { asm volatile("s_waitcnt vmcnt(0)" ::: "memory"); __syncthreads(); } while (0)
#define RESC(a) do { if (__any((a) < 1.f)) { if (hi == 0) al_l[r32] = (a); asm volatile("s_waitcnt lgkmcnt(0)" ::: "memory"); \
    _Pragma("unroll") for (int d = 0; d < 4; ++d) _Pragma("unroll") for (int r = 0; r < 16; ++r) o[d][r] *= al_l[crow(r, hi)]; } } while (0)
    const LAS char* Kn0 = lds + L_KN; const LAS char* Kn1 = lds + L_KN + KN_B; const LAS char* Kr0 = lds + L_KR; const LAS char* Kr1 = lds + L_KR + KR_B;
    const int vb0 = (int)(unsigned)(uintptr_t)(lds + L_V) + v_rd_base(lane);
    float m_reg = -1e30f, l_reg = 0.f;
#pragma unroll
    for (int d = 0; d < 4; ++d) o[d] = f32x16{};
    f32x16 pA0, pA1, pB0, pB1; float alA, alB; bf16x8 pa0, pa1, pa2, pa3;
    int sl_prev = 0, sl_cur = V_B, sl_next = 2 * V_B;
#define ROT() do { const int t_ = sl_prev; sl_prev = sl_cur; sl_cur = sl_next; sl_next = t_; } while (0)
    if (TWO) {
    DMA_TILE(0, 0);
    WAITSYNC();
    DMA_TILE(1, V_B);
    qkt<NOPE>(pA0, pA1, Kn0, Kr0, qr, qlds, r32, hi); partialSM(pA0, pA1, m_reg, alA);
    WAITSYNC();
    for (int j = 1; j + 1 < NT; j += 2) {
        DMA_TILE(0, sl_next);
        SBAR(); qkt<NOPE>(pB0, pB1, Kn1, Kr1, qr, qlds, r32, hi);
        finishSM(pA0, pA1, alA, l_reg, pa0, pa1, pa2, pa3); SBAR();
        pv_d0(o, vb0 + sl_prev, pa0, pa1, pa2, pa3); partialSM(pB0, pB1, m_reg, alB);
        RESC(alB);
        WAITSYNC(); ROT();
        DMA_TILE(1, sl_next);
        SBAR(); qkt<NOPE>(pA0, pA1, Kn0, Kr0, qr, qlds, r32, hi);
        finishSM(pB0, pB1, alB, l_reg, pa0, pa1, pa2, pa3); SBAR();
        pv_d0(o, vb0 + sl_prev, pa0, pa1, pa2, pa3); partialSM(pA0, pA1, m_reg, alA);
        RESC(alA);
        WAITSYNC(); ROT();
    }
    SBAR(); qkt<NOPE>(pB0, pB1, Kn1, Kr1, qr, qlds, r32, hi);
    finishSM(pA0, pA1, alA, l_reg, pa0, pa1, pa2, pa3); SBAR();
    pv_d0(o, vb0 + sl_prev, pa0, pa1, pa2, pa3); partialSM(pB0, pB1, m_reg, alB);
    RESC(alB);
    finishSM(pB0, pB1, alB, l_reg, pa0, pa1, pa2, pa3); SBAR();
    pv_d0(o, vb0 + sl_cur, pa0, pa1, pa2, pa3);
    } else {
        const int grp = wid >> 2;
#define BAR() __builtin_amdgcn_s_barrier()
#define VMW() do { if (NOPE) asm volatile("s_waitcnt vmcnt(0)" ::: "memory"); else asm volatile("s_waitcnt vmcnt(1)" ::: "memory"); } while (0)
#define SMB0() do { partialSM(pA0, pA1, m_reg, alA); RESC(alA); finishSM(pA0, pA1, alA, l_reg, pa0, pa1, pa2, pa3); } while (0)
#define SMB() do { if (NOPE) partialSM(pA0, pA1, m_reg, alA); else partialSM_rel(pA0, pA1, m_reg, alA, negm); RESC(alA); finishSM(pA0, pA1, alA, l_reg, pa0, pa1, pa2, pa3); } while (0)
        s16x4 va[8], vbq[8]; f32x16 negm = f32x16{};
#define VLD(dst, D0, vb) do { dst[0] = tr_read<v_rd_off(D0, 0, 0)>(vb); dst[1] = tr_read<v_rd_off(D0, 0, 1)>(vb); dst[2] = tr_read<v_rd_off(D0, 1, 0)>(vb); dst[3] = tr_read<v_rd_off(D0, 1, 1)>(vb); \
                               dst[4] = tr_read<v_rd_off(D0, 2, 0)>(vb); dst[5] = tr_read<v_rd_off(D0, 2, 1)>(vb); dst[6] = tr_read<v_rd_off(D0, 3, 0)>(vb); dst[7] = tr_read<v_rd_off(D0, 3, 1)>(vb); } while (0)
#define PKV(L, H) (bf16x8){L[0], L[1], L[2], L[3], H[0], H[1], H[2], H[3]}
#define VMM(od, src) do { od = __builtin_amdgcn_mfma_f32_32x32x16_bf16(pa0, PKV(src[0], src[1]), od, 0, 0, 0); od = __builtin_amdgcn_mfma_f32_32x32x16_bf16(pa1, PKV(src[2], src[3]), od, 0, 0, 0); \
                           od = __builtin_amdgcn_mfma_f32_32x32x16_bf16(pa2, PKV(src[4], src[5]), od, 0, 0, 0); od = __builtin_amdgcn_mfma_f32_32x32x16_bf16(pa3, PKV(src[6], src[7]), od, 0, 0, 0); } while (0)
#define LGK(n) asm volatile("s_waitcnt lgkmcnt(" #n ")" ::: "memory")
#define MBLOCK(KN, KR, vslot) do { const int vb_ = vb0 + (vslot); __builtin_amdgcn_s_setprio(2);   if (!NOPE) { VLD(va, 0, vb_); SBAR(); } \
            qkt_pipe<NOPE>(pA0, pA1, KN, KR, qr, qlds, r32, hi, negm); SBAR(); if (NOPE) { VLD(va, 0, vb_); SBAR(); } \
            VLD(vbq, 1, vb_); LGK(8); SBAR(); VMM(o[0], va); SBAR(); \
            VLD(va, 2, vb_); LGK(8); SBAR(); VMM(o[1], vbq); SBAR(); \
            VLD(vbq, 3, vb_); LGK(8); SBAR(); VMM(o[2], va); SBAR(); \
            LGK(0); SBAR(); VMM(o[3], vbq); SBAR(); __builtin_amdgcn_s_setprio(0); } while (0)
        DMA_TILE(0, 0);
        if (grp == 1) DMA_TILE(1, V_B);
        asm volatile("s_waitcnt vmcnt(0)" ::: "memory"); __syncthreads();
        if (grp == 1) { BAR(); }
        SBAR(); qkt<NOPE>(pA0, pA1, Kn0, Kr0, qr, qlds, r32, hi); SBAR();
        if (grp == 0) { DMA_TILE(1, V_B); PREFETCH(); }
        if (grp == 1) VMW();
        BAR();
        if (grp == 1) { DMA_TILE(0, 2 * V_B); PREFETCH(); }
        SMB0();
        if (!NOPE) { const float nm = -m_reg;
#pragma unroll
          for (int r = 0; r < 16; ++r) negm[r] = nm;
          asm volatile("" : "+v"(negm)); }
        if (grp == 0) VMW();
        BAR();
        int s0 = 0, s1 = V_B, s2 = 2 * V_B;
#define ROT3() do { const int t_ = s0; s0 = s1; s1 = s2; s2 = t_; } while (0)
        for (int j = 1; j + 1 < NT; j += 2) {
            MBLOCK(Kn1, Kr1, s0);
            if (grp == 1) VMW();
            BAR();
            if (grp == 0) { DMA_TILE(0, s2); PREFETCH(); }
            if (grp == 1) { DMA_TILE(1, s0); PREFETCH(); }
            SMB();
            if (grp == 0) VMW();
            BAR();
            ROT3();
            MBLOCK(Kn0, Kr0, s0);
            if (grp == 1) VMW();
            BAR();
            if (grp == 0) { DMA_TILE(1, s2); PREFETCH(); }
            if (grp == 1 && j + 3 < NT) { DMA_TILE(0, s0); PREFETCH(); }
            SMB();
            if (grp == 0) VMW();
            BAR();
            ROT3();
        }
        MBLOCK(Kn1, Kr1, s0);
        if (grp == 1) VMW();
        BAR();
        SMB();
        BAR();
        ROT3();
        { const int vb_ = vb0 + s0; VLD(va, 0, vb_); VLD(vbq, 1, vb_); LGK(8); SBAR(); VMM(o[0], va); SBAR();
          VLD(va, 2, vb_); LGK(8); SBAR(); VMM(o[1], vbq); SBAR();
          VLD(vbq, 3, vb_); LGK(8); SBAR(); VMM(o[2], va); SBAR();
          LGK(0); SBAR(); VMM(o[3], vbq); SBAR(); }
        if (grp == 0) BAR();
        __builtin_amdgcn_s_setprio(0);
#undef BAR
#undef VMW
#undef SMB
#undef SMB0
#undef VLD
#undef PKV
#undef VMM
#undef LGK
#undef MBLOCK
#undef ROT3
    }
    if (hi == 0) li_l[r32] = l_reg; asm volatile("s_waitcnt lgkmcnt(0)" ::: "memory");
#pragma unroll
    for (int r = 0; r < 16; ++r) { const float rl = __builtin_amdgcn_rcpf(li_l[crow(r, hi)]);
#pragma unroll
        for (int d = 0; d < 4; ++d) o[d][r] *= rl; }
    asm volatile("s_waitcnt vmcnt(0)" ::: "memory");
    __syncthreads();
#undef GLDS
#undef DMA_TILE
#undef WAITSYNC
#undef PREFETCH
#undef RESC
#undef ROT
}
#undef SBAR
}

#define XB_TMO      128
#define XB_XCNT(j)  (256  + 64 * (j))
#define XB_XSUB(j)  (1280 + 64 * (j))
#define XB_XGEN(j)  (2304 + 64 * (j))
#define XB_TOP      3328
#define XB_TOPGEN   3392
#define XCD_BAR_WORDS 3456
#define XB_SPIN_CAP (1u << 18)

__device__ __forceinline__ unsigned xb_ld(unsigned* p)              { return __hip_atomic_load(p, __ATOMIC_RELAXED, __HIP_MEMORY_SCOPE_AGENT); }
__device__ __forceinline__ unsigned xb_add(unsigned* p, unsigned v) { return __hip_atomic_fetch_add(p, v, __ATOMIC_RELAXED, __HIP_MEMORY_SCOPE_AGENT); }
__device__ __forceinline__ unsigned xb_xcc_id() { return (unsigned)__builtin_amdgcn_s_getreg((3 << 11) | 20) & 0xFu; }
#define XB_SPIN(cond, bar) do { unsigned _sp = 0; while (cond) { __builtin_amdgcn_s_sleep(1); \
    if ((++_sp & 255u) == 0u) { if (xb_ld(&(bar)[XB_TMO])) break; if (_sp > XB_SPIN_CAP) { atomicAdd(&(bar)[XB_TMO], 1u); break; } } } } while (0)

struct XcdBarrier {
    unsigned* bar; unsigned x;
    volatile LAS unsigned* st;
};

__device__ __forceinline__ XcdBarrier xcd_barrier_post(unsigned* bar, volatile LAS unsigned* st) {
    XcdBarrier b; b.bar = bar; b.x = xb_xcc_id(); b.st = st;
    if (threadIdx.x == 0) (void)xb_add(&bar[XB_XCNT(b.x)], 1u);
    return b;
}
__device__ __forceinline__ void xcd_barrier_complete(unsigned* bar, unsigned x, unsigned& nloc, unsigned& nx) {
    const unsigned G = gridDim.x * gridDim.y * gridDim.z;
    unsigned sum, cnt, mine, sp = 0u;
    for (;;) {
        sum = 0u; cnt = 0u; mine = 0u;
#pragma unroll
        for (unsigned j = 0; j < 16; ++j) { const unsigned c = xb_ld(&bar[XB_XCNT(j)]); sum += c; cnt += (c > 0u) ? 1u : 0u; mine = (j == x) ? c : mine; }
        if (sum == G) break;
        __builtin_amdgcn_s_sleep(1);
        if ((++sp & 255u) == 0u) { if (xb_ld(&bar[XB_TMO])) break; if (sp > XB_SPIN_CAP) { atomicAdd(&bar[XB_TMO], 1u); break; } }
    }
    nloc = mine > 0u ? mine : 1u; nx = cnt > 0u ? cnt : 1u;
}

__device__ __forceinline__ void xcd_barrier(const XcdBarrier& b) {
    asm volatile("s_waitcnt vmcnt(0)" ::: "memory");
    __syncthreads();
    if (threadIdx.x == 0) {
        unsigned* bar = b.bar;
        __builtin_amdgcn_s_waitcnt(0);
        unsigned nloc = b.st[0], nx = b.st[1];
        if (nloc == 0u) { xcd_barrier_complete(bar, b.x, nloc, nx); b.st[0] = nloc; b.st[1] = nx; }
        const unsigned old = xb_add(&bar[XB_XSUB(b.x)], 1u);
        const unsigned gen = old / nloc;
        if (old + 1u == (gen + 1u) * nloc) {
            __builtin_amdgcn_fence(__ATOMIC_RELEASE, "agent");
            asm volatile("s_waitcnt vmcnt(0)" ::: "memory");
            const unsigned og = xb_add(&bar[XB_TOP], 1u);
            const unsigned tg = og / nx;
            if (og + 1u == (tg + 1u) * nx) xb_add(&bar[XB_TOPGEN], 1u);
            else XB_SPIN(xb_ld(&bar[XB_TOPGEN]) == tg, bar);
            __builtin_amdgcn_fence(__ATOMIC_ACQUIRE, "agent");
            xb_add(&bar[XB_XGEN(b.x)], 1u);
            asm volatile("s_waitcnt vmcnt(0)" ::: "memory");
        } else {
            XB_SPIN(xb_ld(&bar[XB_XGEN(b.x)]) == gen, bar);
            __builtin_amdgcn_fence(__ATOMIC_ACQUIRE, "agent");
            asm volatile("s_waitcnt vmcnt(0)" ::: "memory");
        }
    }
    __syncthreads();
}


constexpr int N_PHASES_K = 12;
struct Args { const float* in[22]; float* out; unsigned char* ws; int ph_lo, ph_hi; };

__device__ __forceinline__ void p0_tr_item(const float* W, int K, int N, int k0, int n0, bf16_t* WT, int drow0, const float* gk, LAS float* scr, int lane) {
#pragma unroll 8
    for (int i = 0; i < 32; ++i) { const int kk = 2 * i + (lane >> 5); float v = W[(size_t)(k0 + kk) * N + n0 + (lane & 31)]; if (gk) v *= gk[k0 + kk]; scr[kk * 33 + (lane & 31)] = v; }
    asm volatile("s_waitcnt lgkmcnt(0)" ::: "memory");
    const int c = lane & 7;
#pragma unroll
    for (int j = 0; j < 4; ++j) { const int n = (lane >> 3) + 8 * j; const LAS float* s = scr + (8 * c) * 33 + n;
        u32x4 o; o.x = cvt_pk_bf16(s[0 * 33], s[1 * 33]); o.y = cvt_pk_bf16(s[2 * 33], s[3 * 33]); o.z = cvt_pk_bf16(s[4 * 33], s[5 * 33]); o.w = cvt_pk_bf16(s[6 * 33], s[7 * 33]);
        *(u32x4*)(WT + (size_t)(drow0 + n) * K + k0 + 8 * c) = o; }
    asm volatile("s_waitcnt lgkmcnt(0)" ::: "memory");
}

template <int MODE>
__device__ __forceinline__ void norm_row(const float* xrow, const float* g, const float* mod_s, const float* bada, int shoff, int scoff, void* orow, int lane) {
    const f32x4* xr = (const f32x4*)xrow + lane;
    f32x4 v[8]; float s2 = 0.f;
#pragma unroll
    for (int j = 0; j < 8; ++j) { v[j] = xr[64 * j]; s2 += (v[j].x * v[j].x + v[j].y * v[j].y) + (v[j].z * v[j].z + v[j].w * v[j].w); }
    const float rstd = 1.0f / sqrtf(wave_sum(s2) * (1.f / DM) + EPS);
#pragma unroll
    for (int j = 0; j < 8; ++j) {
        const int c = (lane + 64 * j) * 4;
        const f32x4 gg = *(const f32x4*)(g + c);
        f32x4 y = v[j] * rstd * gg;
        if (MODE == 0) {
            const f32x4 sh = *(const f32x4*)(mod_s + shoff + c) + *(const f32x4*)(bada + shoff + c);
            const f32x4 sc = *(const f32x4*)(mod_s + scoff + c) + *(const f32x4*)(bada + scoff + c);
            y = y * (sc + 1.0f) + sh;
            u32x2 w; w.x = cvt_pk_bf16(y.x, y.y); w.y = cvt_pk_bf16(y.z, y.w);
            *((u32x2*)orow + lane + 64 * j) = w;
        } else {
            *((f32x4*)orow + lane + 64 * j) = y;
        }
    }
}

__global__ void __launch_bounds__(NWAVES * 64, 2) mk_fwd(Args args) {
    extern __shared__ __attribute__((aligned(16))) unsigned char lds_raw[];
    LAS unsigned char* lds = (LAS unsigned char*)lds_raw;
    const int tid = threadIdx.x, lane = tid & 63, wave = __builtin_amdgcn_readfirstlane(tid >> 6);
    const int G = gridDim.x, bx = blockIdx.x;
    const int gw = bx * NWAVES + wave, NGW = G * NWAVES;
#define ws (args.ws)
#define xin (args.in[0])
#define cvec (args.in[1])
#define ctx (args.in[2])
#define c_ctx (args.in[3])
#define w_ada (args.in[4])
#define b_ada (args.in[5])
#define norm1_g (args.in[6])
#define norm2_g (args.in[7])
#define w_in (args.in[8])
#define da_lambda (args.in[9])
#define da_g (args.in[10])
#define mla_q_g (args.in[11])
#define mla_kv_g (args.in[12])
#define w_uq (args.in[13])
#define w_ukv (args.in[14])
#define w_o_da (args.in[15])
#define w_o_mla (args.in[16])
#define w_out (args.in[17])
#define w_gate (args.in[18])
#define w_up (args.in[19])
#define w_down (args.in[20])
#define final_g (args.in[21])
#define out (args.out)
#define mod ((float*)(ws + WS_MOD))
#define rope ((f32x2*)(ws + WS_ROPE))
#define rstd_q ((float*)(ws + WS_RSQ))
#define rstd_kv ((float*)(ws + WS_RSKV))
#define WinT ((bf16_t*)(ws + WS_WIN))
#define WuqT ((bf16_t*)(ws + WS_WUQ))
#define WukvT ((bf16_t*)(ws + WS_WUKV))
#define WodaT ((bf16_t*)(ws + WS_WODA))
#define WomlaT ((bf16_t*)(ws + WS_WOMLA))
#define WoutT ((bf16_t*)(ws + WS_WOUT))
#define WguT ((bf16_t*)(ws + WS_WGU))
#define WdT ((bf16_t*)(ws + WS_WD))
#define HB ((bf16_t*)(ws + WS_H))
#define Z ((bf16_t*)(ws + WS_Z))
#define MQ ((bf16_t*)(ws + WS_MQ))
#define KV HB
#define Y HB
#define H2 HB
#define ACT Z
#define stash ((float*)((unsigned char*)out + OUT_STASH))
#define OMLA ((bf16_t*)((unsigned char*)out + OUT_OMLA))
#define ODA ((bf16_t*)((unsigned char*)out + OUT_ODA))

    if (tid < 64) ((LAS unsigned*)(lds + LDS_MISC))[tid] = 0u;
    __syncthreads();
    XcdBarrier xbar = xcd_barrier_post((unsigned*)(ws + WS_BAR), (volatile LAS unsigned*)(lds + LDS_MISC));
    const int lo = args.ph_lo, hi = args.ph_hi;
#ifndef PH_MASK
#define PH_MASK 0xFFF
#endif
#define IN(k) (((PH_MASK >> (k)) & 1) && lo <= (k) && (k) < hi)
#ifndef PROBE_DUP
#define PROBE_DUP -1
#endif
#define REP(k) for (int rep_ = 0; rep_ < ((PROBE_DUP) == (k) ? 2 : 1); ++rep_)
#define SEAM(k) do { if (IN(k) && IN((k) + 1)) { if (lo < 0) cg::this_grid().sync(); xcd_barrier(xbar); } } while (0)

    if (IN(0)) REP(0) {
        LAS float* scr = (LAS float*)(lds + wave * 16384);
        constexpr int I_IN = 32 * 250, I_UQ = 8 * 48, I_UKV = 4 * 64, I_O = 16 * 64, I_OUT = 32 * 64, I_G = 32 * 176, I_D = 88 * 64;
        constexpr int I_PAD = 192, I_ROPE = 32, I_ADA = 32 * 48;
        constexpr int NITEMS = I_ADA + I_IN + I_UQ + I_UKV + 2 * I_O + I_OUT + 2 * I_G + I_D + I_PAD + I_ROPE;
        for (int it = gw; it < NITEMS; it += NGW) {
            int r = it;
            if (r < I_ADA) {
                const int kc = r / 48, cb = r % 48, n = cb * 256 + lane * 4;
                f32x4 a0 = {0, 0, 0, 0}, a1 = a0, a2 = a0;
#pragma unroll 8
                for (int kk = 0; kk < 64; ++kk) { const int k = kc * 64 + kk;
                    const f32x4 w = *(const f32x4*)(w_ada + (size_t)k * MODW + n);
                    const float c0 = cvec[k], c1 = cvec[DM + k], c2 = c_ctx[k];
                    a0 += w * (c0 * sigmoidf_(c0)); a1 += w * (c1 * sigmoidf_(c1)); a2 += w * (c2 * sigmoidf_(c2)); }
#pragma unroll
                for (int j = 0; j < 4; ++j) { atomicAdd(mod + n + j, a0[j]); atomicAdd(mod + MODW + n + j, a1[j]); atomicAdd(mod + 2 * MODW + n + j, a2[j]); }
                continue; } r -= I_ADA;
            if (r < I_IN) { const int kb = r / 250, nb = r % 250, n0 = nb * 32; p0_tr_item(w_in, DM, INW, kb * 64, n0, WinT, n0 + (n0 >= 3904 ? 192 : 0), nullptr, scr, lane); continue; } r -= I_IN;
            if (r < I_UQ) { const int kb = r / 48, nb = r % 48; p0_tr_item(w_uq, 512, MQW, kb * 64, nb * 32, WuqT, nb * 32, mla_q_g, scr, lane); continue; } r -= I_UQ;
            if (r < I_UKV) { const int kb = r / 64, nb = r % 64; p0_tr_item(w_ukv, 256, KVW, kb * 64, nb * 32, WukvT, nb * 32, mla_kv_g, scr, lane); continue; } r -= I_UKV;
            if (r < I_O) { const int kb = r / 64, nb = r % 64; p0_tr_item(w_o_da, OW, DM, kb * 64, nb * 32, WodaT, nb * 32, nullptr, scr, lane); continue; } r -= I_O;
            if (r < I_O) { const int kb = r / 64, nb = r % 64; p0_tr_item(w_o_mla, OW, DM, kb * 64, nb * 32, WomlaT, nb * 32, nullptr, scr, lane); continue; } r -= I_O;
            if (r < I_OUT) { const int kb = r / 64, nb = r % 64; p0_tr_item(w_out, DM, DM, kb * 64, nb * 32, WoutT, nb * 32, nullptr, scr, lane); continue; } r -= I_OUT;
            if (r < I_G) { const int kb = r / 176, nb = r % 176, n0 = nb * 32; p0_tr_item(w_gate, DM, FF, kb * 64, n0, WguT, (n0 >> 7) * 256 + (n0 & 127), nullptr, scr, lane); continue; } r -= I_G;
            if (r < I_G) { const int kb = r / 176, nb = r % 176, n0 = nb * 32; p0_tr_item(w_up, DM, FF, kb * 64, n0, WguT, (n0 >> 7) * 256 + 128 + (n0 & 127), nullptr, scr, lane); continue; } r -= I_G;
            if (r < I_D) { const int kb = r / 64, nb = r % 64; p0_tr_item(w_down, FF, DM, kb * 64, nb * 32, WdT, nb * 32, nullptr, scr, lane); continue; } r -= I_D;
            if (r < I_PAD) { u32x4* p = (u32x4*)(WinT + (size_t)(3904 + r) * DM) + lane; const u32x4 z = {0, 0, 0, 0};
#pragma unroll
                for (int j = 0; j < 4; ++j) p[64 * j] = z; continue; } r -= I_PAD;
            { const int e = r * 64 + lane, pos = e >> 4, i = e & 15;
              const float inv = exp2f(-(float)i * (13.287712379549449f / 16.0f)); const float a = (float)pos * inv;
              rope[e] = (f32x2){cosf(a), sinf(a)}; }
        }
    }
    SEAM(0);
    if (IN(1)) REP(1) {
        for (int r = gw; r < MR; r += NGW) {
            const int b = r / ROWS_B, rr = r % ROWS_B;
            const float* src = (rr < CTX) ? ctx + ((size_t)b * CTX + rr) * DM : xin + ((size_t)b * SEQ + (rr - CTX)) * DM;
            const int s = (rr < CTX) ? 2 : b;
            norm_row<0>(src, norm1_g, mod + s * MODW, b_ada, 0, DM, HB + (size_t)r * DM, lane);
        }
    }
    SEAM(1);
    if (IN(2)) REP(2) {
        { const u32x4* src = (const u32x4*)rope; LAS u32x4* dst = (LAS u32x4*)(lds + LDS_ROPE);
          dst[tid] = src[tid]; dst[tid + 512] = src[tid + 512]; __syncthreads(); }
        pg8::Gemm g{HB, WinT, DM, DM}; pg8::StaticOrder S; S.init(MR, ZW, G, bx, 0);
        pg8::EpiIn E{Z, (const LAS f32x2*)(lds + LDS_ROPE), rstd_q, rstd_kv};
        pg8::gemm_phase(lds, g, S, E);
    }
    SEAM(2);
    if (IN(4)) REP(4) {
        { const u32x4* src = (const u32x4*)rope; LAS u32x4* dst = (LAS u32x4*)(lds + LDS_ROPE);
          dst[tid] = src[tid]; dst[tid + 512] = src[tid + 512]; __syncthreads(); }
        { pg8::Gemm g{Z + Z_CQ, WuqT, ZW, 512}; pg8::StaticOrder S; S.init(ML, MQW, G, bx, 1);
          pg8::EpiMq E{MQ, (const LAS f32x2*)(lds + LDS_ROPE), rstd_q}; pg8::gemm_phase(lds, g, S, E); }
        { pg8::Gemm g{Z + Z_CKV, WukvT, ZW, 256}; pg8::StaticOrder S; S.init(MR, KVW, G, (bx + 128) % G, 0);
          pg8::EpiKv E{KV, rstd_kv}; pg8::gemm_phase(lds, g, S, E); }
    }
    SEAM(4);
    if (IN(5)) {
        const int r32 = lane & 31, hh = lane >> 5;
        float lam;
        { const float a = da_lambda[lane] * da_lambda[64 + lane], b2 = da_lambda[128 + lane] * da_lambda[192 + lane];
          lam = __expf(wave_sum(a)) - __expf(wave_sum(b2)) + LAM_INIT; }
        const int vcu = (G % 8 == 0) ? (bx & 7) * (G >> 3) + (bx >> 3) : bx;
#ifndef ATT_SKIP_DA
        for (int w = vcu; w < 256; w += G)
        for (int slot = 0; slot < 2; ++slot) REP(50) {
            const int pr = (w >> 5) * 2 + slot, qt = w & 31, b = pr >> 3, h = pr & 7;
            const int rowq = b * ROWS_B + CTX + qt * 256 + wave * 32;
            const bf16_t* Zb = Z + (size_t)b * ROWS_B * ZW;
            f32x16 o[4];
            float* st = stash + ((size_t)(bx * NWAVES + wave) * 64) * 64 + lane * 4;
            for (int sub = 0; sub < 2; ++sub) {
                const int sh_ = 2 * h + sub;
                att::attn_pass<false, ZW, ZW, ZW, ATT_TWO_DA>((LAS char*)lds, Z + (size_t)(rowq + r32) * ZW + Z_DQ + sh_ * 64 + hh * 8, nullptr,
                                      Zb + Z_DK + sh_ * 64, Zb + Z_DV + h * 128, o);
                if (sub == 0) {
                    f32x4* stp = (f32x4*)st; asm volatile("" : "+v"(stp));
#pragma unroll
                    for (int d = 0; d < 4; ++d)
#pragma unroll
                        for (int r = 0; r < 16; r += 4) stp[(d * 4 + (r >> 2)) * 64] = (f32x4){o[d][r], o[d][r + 1], o[d][r + 2], o[d][r + 3]};
                }
            }
            float ss[16];
#pragma unroll
            for (int r = 0; r < 16; ++r) ss[r] = 0.f;
#pragma unroll
            for (int d = 0; d < 4; ++d) {
                const f32x4* stp = (const f32x4*)st + d * 256; asm volatile("" : "+v"(stp));
#pragma unroll
                for (int r = 0; r < 16; r += 4) { const f32x4 sv = stp[(r >> 2) * 64];
#pragma unroll
                    for (int q = 0; q < 4; ++q) { const float v = sv[q] - lam * o[d][r + q]; o[d][r + q] = v; ss[r + q] += v * v; } } }
#pragma unroll
            for (int r = 0; r < 16; ++r) {
                float s = ss[r];
                s += __shfl_xor(s, 1); s += __shfl_xor(s, 2); s += __shfl_xor(s, 4); s += __shfl_xor(s, 8); s += __shfl_xor(s, 16);
                ss[r] = (1.0f - LAM_INIT) / sqrtf(s * (1.f / 128.f) + EPS);
            }
#pragma unroll
            for (int d = 0; d < 4; ++d) { const float gg = da_g[d * 32 + r32];
                bf16_t* zo = ODA + (size_t)(rowq + 4 * hh) * OW + h * 128 + d * 32 + r32; asm volatile("" : "+v"(zo));
#pragma unroll
                for (int r = 0; r < 16; ++r) {
                    const float v = o[d][r] * ss[r] * gg;
                    zo[(size_t)((r & 3) + 8 * (r >> 2)) * OW] = (bf16_t)(cvt_pk_bf16(v, v) & 0xffffu);
                } }
        }
#endif
#ifndef ATT_SKIP_MLA
        for (int w = vcu; w < 256; w += G)
        for (int slot = 0; slot < 2; ++slot) REP(51) {
            const int pr = (w >> 5) * 2 + slot, qt = w & 31, b = pr >> 3, h = pr & 7;
            const int rowq = b * ROWS_B + CTX + qt * 256 + wave * 32;
            const bf16_t* Zb = Z + (size_t)b * ROWS_B * ZW;
            f32x16 o[4];
            att::attn_pass<true, KVW, ZW, KVW, ATT_TWO_MLA>((LAS char*)lds, MQ + (size_t)(rowq + r32) * MQW + h * 192 + hh * 8,
                                 KV + (size_t)b * ROWS_B * KVW + h * 256, Zb + Z_KR, KV + (size_t)b * ROWS_B * KVW + h * 256 + 128, o);
#pragma unroll
            for (int d = 0; d < 4; ++d) {
                bf16_t* oo = OMLA + (size_t)(rowq + 4 * hh) * OW + h * 128 + d * 32 + r32; asm volatile("" : "+v"(oo));
#pragma unroll
                for (int r = 0; r < 16; ++r)
                    oo[(size_t)((r & 3) + 8 * (r >> 2)) * OW] = (bf16_t)(cvt_pk_bf16(o[d][r], o[d][r]) & 0xffffu); }
        }
#endif
    }
    SEAM(5);
    if (IN(6)) REP(6) {
        { pg8::Gemm g{ODA, WodaT, OW, OW}; pg8::StaticOrder S; S.init(ML, DM, G, bx, 1);
          pg8::EpiMerge<false> E{Y, Z + Z_GA}; pg8::gemm_phase(lds, g, S, E); }
        { pg8::Gemm g{OMLA, WomlaT, OW, OW}; pg8::StaticOrder S; S.init(ML, DM, G, bx, 1);
          pg8::EpiMerge<true> E{Y, Z + Z_GB}; pg8::gemm_phase(lds, g, S, E); }
    }
    SEAM(6);
    if (IN(7)) REP(7) {
        pg8::Gemm g{Y, WoutT, DM, DM}; pg8::StaticOrder S; S.init(ML, DM, G, bx, 1);
        pg8::EpiRes E{xin, out, mod, b_ada, 2 * DM}; pg8::gemm_phase(lds, g, S, E);
    }
    SEAM(7);
    if (IN(8)) REP(8) {
        for (int l = gw; l < ML; l += NGW) {
            const int b = l >> 13, r = l + 256 * (1 + b);
            norm_row<0>(out + (size_t)l * DM, norm2_g, mod + b * MODW, b_ada, 3 * DM, 4 * DM, H2 + (size_t)r * DM, lane);
        }
    }
    SEAM(8);
    if (IN(9)) REP(9) {
        pg8::Gemm g{H2, WguT, DM, DM}; pg8::StaticOrder S; S.init(ML, 2 * FF, G, bx, 1);
        pg8::EpiSwiglu E{ACT}; pg8::gemm_phase(lds, g, S, E);
    }
    SEAM(9);
    if (IN(10)) {
        pg8::Gemm g{ACT, WdT, FF, FF}; pg8::StaticOrder S; S.init(ML, DM, G, bx, 1);
        pg8::EpiRes E{out, out, mod, b_ada, 5 * DM}; pg8::gemm_phase(lds, g, S, E);
    }
    SEAM(10);
    if (IN(11)) {
        for (int l = gw; l < ML; l += NGW) norm_row<1>(out + (size_t)l * DM, final_g, nullptr, nullptr, 0, 0, out + (size_t)l * DM, lane);
    }
#if PROBE_DUP == 99
    if (lo == 0 && hi == N_PHASES_K) { for (int i = 0; i < 10; ++i) xcd_barrier(xbar); }
#endif
#undef IN
#undef SEAM
}

#undef ws
#undef xin
#undef cvec
#undef ctx
#undef c_ctx
#undef w_ada
#undef b_ada
#undef norm1_g
#undef norm2_g
#undef w_in
#undef da_lambda
#undef da_g
#undef mla_q_g
#undef mla_kv_g
#undef w_uq
#undef w_ukv
#undef w_o_da
#undef w_o_mla
#undef w_out
#undef w_gate
#undef w_up
#undef w_down
#undef final_g
#undef out
#undef mod
#undef rope
#undef rstd_q
#undef rstd_kv
#undef WinT
#undef WuqT
#undef WukvT
#undef WodaT
#undef WomlaT
#undef WoutT
#undef WguT
#undef WdT
#undef HB
#undef Z
#undef MQ
#undef KV
#undef Y
#undef H2
#undef ACT
#undef stash
#undef OMLA
#undef ODA
constexpr int N_PHASES = 12;

extern "C" void kernel_launch(void* const* d_in, const int* in_sizes, int n_in, void* d_out, int out_size, void* d_ws, size_t ws_size, hipStream_t stream) {
    static int grid = 0;
    if (grid == 0) {
        if (n_in != 22 || out_size != ML * DM || ws_size < WS_END) { fprintf(stderr, "kernel_launch: unexpected shapes (n_in %d out %d ws %zu)\n", n_in, out_size, ws_size); grid = -1; return; }
        int dev = 0, cus = 0, per_cu = 0;
        hipGetDevice(&dev); hipDeviceGetAttribute(&cus, hipDeviceAttributeMultiprocessorCount, dev);
        if (hipFuncSetAttribute((const void*)mk_fwd, hipFuncAttributeMaxDynamicSharedMemorySize, LDS_BYTES) != hipSuccess) { fprintf(stderr, "kernel_launch: hipFuncSetAttribute failed\n"); grid = -1; return; }
        if (hipOccupancyMaxActiveBlocksPerMultiprocessor(&per_cu, (const void*)mk_fwd, NWAVES * 64, LDS_BYTES) != hipSuccess || per_cu < 1) { fprintf(stderr, "kernel_launch: occupancy query says %d\n", per_cu); per_cu = 1; }
        (void)hipGetLastError();
        grid = cus;
        if (grid > 256) grid = 256;
    }
    if (grid < 0) return;
    (void)hipMemsetAsync((char*)d_ws + WS_MOD, 0, CTL_ZERO_BYTES, stream);
    Args a{};
    for (int i = 0; i < 22; ++i) a.in[i] = (const float*)d_in[i];
    a.out = (float*)d_out; a.ws = (unsigned char*)d_ws;
#if MK_PER_PHASE
    for (int p = 0; p < N_PHASES; ++p) { a.ph_lo = p; a.ph_hi = p + 1; hipLaunchKernelGGL(mk_fwd, dim3(grid), dim3(NWAVES * 64), LDS_BYTES, stream, a); }
#else
    a.ph_lo = 0; a.ph_hi = N_PHASES;
    void* kargs[] = {&a};
    hipError_t e = hipLaunchCooperativeKernel((const void*)mk_fwd, dim3(grid), dim3(NWAVES * 64), kargs, LDS_BYTES, stream);
    if (e != hipSuccess) fprintf(stderr, "cooperative launch failed: %s (grid %d)\n", hipGetErrorString(e), grid);
#endif
}
```

```cpp
#include <hip/hip_runtime.h>
#include <hip/hip_cooperative_groups.h>
#include <cstdio>
#include <cstdint>
namespace cg = cooperative_groups;

#define LAS __attribute__((address_space(3)))
typedef unsigned short bf16_t;
typedef short bf16x8 __attribute__((ext_vector_type(8)));
typedef short s16x4 __attribute__((ext_vector_type(4)));
typedef float f32x2 __attribute__((ext_vector_type(2)));
typedef float f32x4 __attribute__((ext_vector_type(4)));
typedef float f32x16 __attribute__((ext_vector_type(16)));
typedef unsigned u32x2 __attribute__((ext_vector_type(2)));
typedef unsigned u32x4 __attribute__((ext_vector_type(4)));

#ifndef ATT_TWO_DA
#define ATT_TWO_DA false
#endif
#ifndef ATT_TWO_MLA
#define ATT_TWO_MLA false
#endif
#ifndef MK_PER_PHASE
#define MK_PER_PHASE 0
#endif

constexpr int DM = 2048, NB = 2, SEQ = 8192, CTX = 256;
constexpr int ROWS_B = SEQ + CTX;
constexpr int MR = NB * ROWS_B;
constexpr int ML = NB * SEQ;
constexpr int ZW = 8192;
constexpr int Z_DQ = 0, Z_DK = 1024, Z_DV = 2048, Z_CQ = 3072, Z_CKV = 3584, Z_KR = 3840, Z_GA = 4096, Z_GB = 6144;
constexpr int FF = 5632, INW = 8000, MODW = 6 * DM;
constexpr int MQW = 1536, KVW = 2048, OW = 1024;
constexpr float EPS = 1e-6f;
constexpr float LOG2E = 1.4426950408889634f;
constexpr float C_DA = 0.125f * LOG2E;
constexpr float C_MLA = 0.07216878364870322f * LOG2E;
constexpr float LAM_INIT = 0.2f;

constexpr size_t MiB = 1u << 20;
constexpr size_t WS_MOD = 0;
constexpr size_t MOD_BYTES = 3 * MODW * 4;
constexpr size_t WS_BAR = 160 * 1024;
constexpr size_t WS_RSQ = 176 * 1024;
constexpr size_t WS_RSKV = 244 * 1024;
constexpr size_t CTL_ZERO_BYTES = 312 * 1024;
constexpr size_t WS_ROPE = 768 * 1024;
constexpr size_t WS_WIN = 1 * MiB;
constexpr size_t WS_WUQ = 33 * MiB;
constexpr size_t WS_WUKV = 35 * MiB;
constexpr size_t WS_WODA = 36 * MiB;
constexpr size_t WS_WOMLA = 40 * MiB;
constexpr size_t WS_WOUT = 44 * MiB;
constexpr size_t WS_WGU = 52 * MiB;
constexpr size_t WS_WD = 96 * MiB;
constexpr size_t WS_H = 118 * MiB;
constexpr size_t WS_Z = 184 * MiB;
constexpr size_t WS_MQ = 448 * MiB;
constexpr size_t WS_END = 498 * MiB;
constexpr size_t OUT_STASH = 0;
constexpr size_t OUT_OMLA = 32 * MiB;
constexpr size_t OUT_ODA = 66 * MiB;

constexpr int NWAVES = 8;
constexpr int LDS_ROPE = 131072;
constexpr int LDS_MISC = 154 * 1024;
constexpr int LDS_BYTES = 154 * 1024 + 256;

__device__ __forceinline__ unsigned cvt_pk_bf16(float lo, float hi) { unsigned r; asm volatile("v_cvt_pk_bf16_f32 %0, %1, %2" : "=v"(r) : "v"(lo), "v"(hi)); return r; }
__device__ __forceinline__ float bf_lo(unsigned w) { return __uint_as_float(w << 16); }
__device__ __forceinline__ float bf_hi(unsigned w) { return __uint_as_float(w & 0xffff0000u); }
__device__ __forceinline__ float wave_sum(float v) {
#pragma unroll
    for (int o = 1; o < 64; o <<= 1) v += __shfl_xor(v, o);
    return v;
}
__device__ __forceinline__ float sigmoidf_(float x) { return __builtin_amdgcn_rcpf(1.0f + __expf(-x)); }
__device__ __forceinline__ int r_to_l(int r) { return r - 256 * (1 + (r >= ROWS_B ? 1 : 0)); }

namespace pg8 {
constexpr int BM = 256, BK = 64, HALF = 128, HTB = HALF * BK * 2, STAGE_BYTES = 8 * HTB, NXCD = 8, WGM = 8;
__host__ __device__ __forceinline__ int lds_byte(int r, int c) { const int st = (r >> 4) * 2 + (c >> 5), rr = r & 15, cc = c & 31, ob = rr * 64 + cc * 2; return st * 1024 + (ob ^ (((ob >> 9) & 1) << 5)); }
__host__ __device__ __forceinline__ void stage_rc(int b, int& R, int& C) { const int st = b / 1024, sb = b % 1024, swz = sb ^ (((sb >> 9) & 1) << 5); R = (st >> 1) * 16 + swz / 64; C = (st & 1) * 32 + (swz % 64) / 2; }
__host__ __device__ __forceinline__ int perm32(int rho) { const int n = rho >> 4, i = rho & 15; return 8 * (i >> 2) + 4 * n + (i & 3); }

struct Unit { int pm, pn; };
struct Gemm { const bf16_t* A; const bf16_t* Bt; int lda; int K; };

struct StaticOrder {
    int nM, nN, nwg, G, c, latent;
    __device__ void init(int M, int N, int G_, int c_, int latent_) { nM = M / BM; nN = N / BM; nwg = nM * nN; G = G_; c = c_; latent = latent_; }
    __device__ bool next(int i, Unit& u) const {
        const long L = (long)i * G + c; if (L >= nwg) return false;
        int wgid = (int)L; { const int q = nwg / NXCD, r = nwg % NXCD, xcd = wgid % NXCD, off = wgid / NXCD; wgid = (xcd < r ? xcd * (q + 1) : r * (q + 1) + (xcd - r) * q) + off; }
        const int nig = WGM * nN, gid = wgid / nig, fm = gid * WGM, gsz = (nM - fm) < WGM ? (nM - fm) : WGM;
        u.pm = fm + ((wgid % nig) % gsz); u.pn = (wgid % nig) / gsz;
        if (latent) u.pm += 1 + (u.pm >= 32 ? 1 : 0);
        return true;
    }
};

template <class Epi>
__device__ __forceinline__ void gemm_phase(LAS unsigned char* lds, const Gemm g, const StaticOrder& S, const Epi& E) {
    int tid_ = threadIdx.x; asm volatile("" : "+v"(tid_));
    const int tid = tid_, wid = __builtin_amdgcn_readfirstlane(tid >> 6), lane = tid & 63, wr = wid >> 2, wc = wid & 3, fr = lane & 15, fq = lane >> 4;
    const int K = g.K, nt = K / BK, lda = g.lda;
    unsigned voffA[2], voffB[2];
#pragma unroll
    for (int i = 0; i < 2; ++i) { int R, C; stage_rc(tid * 16 + i * 8192, R, C); const int Rb = Epi::PERM ? ((R & ~31) + perm32(R & 31)) : R;
        voffA[i] = (unsigned)(R * lda + C) * 2u; voffB[i] = (unsigned)(Rb * K + C) * 2u; }
    const size_t kstep = (size_t)(BK * 2);
    const size_t hstepA = (size_t)HALF * lda * 2, hstepB = (size_t)HALF * K * 2;
    const size_t tstepA = 2 * hstepA, tstepB = 2 * hstepB;
    const unsigned ldsw = (unsigned)wid * 1024u;
    const int aoff = lds_byte(wr * 64 + fr, fq * 8), boff = lds_byte(wc * 32 + fr, fq * 8);
#define PG8_SA(b, h) (((b) * 2 + (h)) * HTB)
#define PG8_SB(b, h) ((4 + (b) * 2 + (h)) * HTB)
#define PG8_STAGE(bufoff, gbase, voff) do { _Pragma("unroll") for (int _i = 0; _i < 2; ++_i) \
        __builtin_amdgcn_global_load_lds((const unsigned*)((const char*)(gbase) + (voff)[_i]), (LAS unsigned*)(lds + (bufoff) + ldsw + _i * 8192), 16, 0, 0); } while (0)
#define PG8_LDA(dst, b, h) do { _Pragma("unroll") for (int m = 0; m < 4; ++m) _Pragma("unroll") for (int k = 0; k < 2; ++k) dst[m][k] = *(const LAS bf16x8*)(lds + PG8_SA(b, h) + aoff + m * 2048 + k * 1024); } while (0)
#define PG8_LDB(dst, b, h) do { _Pragma("unroll") for (int n = 0; n < 2; ++n) _Pragma("unroll") for (int k = 0; k < 2; ++k) dst[n][k] = *(const LAS bf16x8*)(lds + PG8_SB(b, h) + boff + n * 2048 + k * 1024); } while (0)
#define PG8_MMA(ai, bj, At, Bt) do { __builtin_amdgcn_s_setprio(1); _Pragma("unroll") for (int m = 0; m < 4; ++m) _Pragma("unroll") for (int n = 0; n < 2; ++n) _Pragma("unroll") for (int k = 0; k < 2; ++k) \
        acc[ai][bj][m][n] = __builtin_amdgcn_mfma_f32_16x16x32_bf16(Bt[n][k], At[m][k], acc[ai][bj][m][n], 0, 0, 0); __builtin_amdgcn_s_setprio(0); } while (0)
#define PG8_WAIT_V(n) asm volatile("s_waitcnt vmcnt(" #n ")" ::: "memory")
#define PG8_WAIT_L(n) asm volatile("s_waitcnt lgkmcnt(" #n ")" ::: "memory")
#define PG8_BAR __builtin_amdgcn_s_barrier()
#define PG8_SCHED __builtin_amdgcn_sched_barrier(0)
    Unit cur, nxt; int ui = 0;
    if (!S.next(0, cur)) return;
    f32x4 acc[2][2][4][2];
#pragma unroll
    for (int a = 0; a < 2; ++a)
#pragma unroll
        for (int b = 0; b < 2; ++b)
#pragma unroll
            for (int m = 0; m < 4; ++m)
#pragma unroll
                for (int n = 0; n < 2; ++n) acc[a][b][m][n] = (f32x4){0.f, 0.f, 0.f, 0.f};
    bf16x8 At[4][2], B0[2][2], B1[2][2];
    const char* cA = (const char*)g.A + (size_t)cur.pm * tstepA; const char* cB = (const char*)g.Bt + (size_t)cur.pn * tstepB;
    PG8_STAGE(PG8_SB(0, 0), cB, voffB); PG8_STAGE(PG8_SB(0, 1), cB + hstepB, voffB); PG8_STAGE(PG8_SA(0, 0), cA, voffA); PG8_STAGE(PG8_SA(0, 1), cA + hstepA, voffA);
    if (wr == 1) PG8_BAR;
    PG8_WAIT_V(2); PG8_BAR;
    PG8_STAGE(PG8_SB(1, 0), cB + kstep, voffB); PG8_STAGE(PG8_SA(1, 0), cA + kstep, voffA); PG8_STAGE(PG8_SB(1, 1), cB + hstepB + kstep, voffB);
    PG8_WAIT_V(6); PG8_BAR;
    for (;;) {
        const bool has_next = S.next(ui + 1, nxt);
        const char* nA = has_next ? (const char*)g.A + (size_t)nxt.pm * tstepA : cA; const char* nB = has_next ? (const char*)g.Bt + (size_t)nxt.pn * tstepB : cB;
        for (int t = 0; t < nt; t += 2) {
            const bool last = (t == nt - 2);
            const char* a1 = cA + (size_t)(t + 1) * kstep;
            const char* a2 = last ? nA : cA + (size_t)(t + 2) * kstep; const char* b2 = last ? nB : cB + (size_t)(t + 2) * kstep;
            const char* a3 = a2 + kstep; const char* b3 = b2 + kstep;
            PG8_LDB(B0, 0, 0); PG8_LDB(B1, 0, 1); PG8_SCHED; PG8_LDA(At, 0, 0); PG8_STAGE(PG8_SA(1, 1), a1 + hstepA, voffA);
            PG8_WAIT_V(8); PG8_WAIT_L(0); PG8_BAR; PG8_MMA(0, 0, At, B0); PG8_MMA(0, 1, At, B1); PG8_BAR; PG8_SCHED;
            PG8_LDA(At, 0, 1); PG8_STAGE(PG8_SB(0, 0), b2, voffB); PG8_STAGE(PG8_SB(0, 1), b2 + hstepB, voffB); PG8_STAGE(PG8_SA(0, 0), a2, voffA);
            PG8_WAIT_V(8); PG8_WAIT_L(0); PG8_BAR; PG8_MMA(1, 0, At, B0); PG8_MMA(1, 1, At, B1); PG8_BAR; PG8_SCHED;
            PG8_LDB(B0, 1, 0); PG8_LDB(B1, 1, 1); PG8_SCHED; PG8_LDA(At, 1, 0); PG8_STAGE(PG8_SA(0, 1), a2 + hstepA, voffA);
            PG8_WAIT_V(8); PG8_WAIT_L(0); PG8_BAR; PG8_MMA(0, 0, At, B0); PG8_MMA(0, 1, At, B1); PG8_BAR; PG8_SCHED;
            PG8_LDA(At, 1, 1); PG8_STAGE(PG8_SB(1, 0), b3, voffB); PG8_STAGE(PG8_SB(1, 1), b3 + hstepB, voffB); PG8_STAGE(PG8_SA(1, 0), a3, voffA);
            PG8_WAIT_V(8); PG8_WAIT_L(0); PG8_BAR; PG8_MMA(1, 0, At, B0); PG8_MMA(1, 1, At, B1); PG8_BAR; PG8_SCHED;
        }
        if (wr == 0) PG8_BAR;
        E(acc, cur, wr, wc, fr, fq);
        if (!has_next) break;
#pragma unroll
        for (int a = 0; a < 2; ++a)
#pragma unroll
            for (int b = 0; b < 2; ++b)
#pragma unroll
                for (int m = 0; m < 4; ++m)
#pragma unroll
                    for (int n = 0; n < 2; ++n) acc[a][b][m][n] = (f32x4){0.f, 0.f, 0.f, 0.f};
        cur = nxt; cA = nA; cB = nB; ++ui;
        if (wr == 1) PG8_BAR;
    }
    PG8_WAIT_V(0);
    PG8_BAR;
#undef PG8_SA
#undef PG8_SB
#undef PG8_STAGE
#undef PG8_LDA
#undef PG8_LDB
#undef PG8_MMA
#undef PG8_WAIT_V
#undef PG8_WAIT_L
#undef PG8_BAR
#undef PG8_SCHED
}

typedef f32x4 Acc[2][2][4][2];

__device__ __forceinline__ void store8(bf16_t* p, f32x4 v0, f32x4 v1) {
    u32x4 w; w.x = cvt_pk_bf16(v0[0], v0[1]); w.y = cvt_pk_bf16(v0[2], v0[3]); w.z = cvt_pk_bf16(v1[0], v1[1]); w.w = cvt_pk_bf16(v1[2], v1[3]);
    *(u32x4*)p = w;
}
__device__ __forceinline__ void rope8(f32x4& v0, f32x4& v1, const LAS f32x2* tab  , int fq) {
    const f32x4 t0 = *(const LAS f32x4*)(tab), t1 = *(const LAS f32x4*)(tab + 2), t2 = *(const LAS f32x4*)(tab + 4), t3 = *(const LAS f32x4*)(tab + 6);
    const float cs[8] = {t0[0], t0[2], t1[0], t1[2], t2[0], t2[2], t3[0], t3[2]};
    const float sn[8] = {t0[1], t0[3], t1[1], t1[3], t2[1], t2[3], t3[1], t3[3]};
    const float sg = (fq < 2) ? -1.f : 1.f;
#pragma unroll
    for (int j = 0; j < 4; ++j) { const float p = __shfl_xor(v0[j], 32); v0[j] = v0[j] * cs[j] + sg * p * sn[j]; }
#pragma unroll
    for (int j = 0; j < 4; ++j) { const float p = __shfl_xor(v1[j], 32); v1[j] = v1[j] * cs[4 + j] + sg * p * sn[4 + j]; }
}

struct EpiIn {
    static constexpr bool PERM = true;
    bf16_t* Z; const LAS f32x2* rope; float* ssq_q; float* ssq_kv;
    __device__ __forceinline__ void operator()(const Acc& acc, const Unit& u, int wr, int wc, int fr, int fq) const {
        const int pn = u.pn, pmb = u.pm % 33;
        const bool ropetile = (pn < 8) || (pn == 15);
        const bool dorope = ropetile && (pmb != 0);
        const bool statt = (pn >= 12 && pn <= 14);
        const float sc = (pn < 4) ? C_DA : 1.f;
        const int t0 = (pmb - 1) * 256;
        const int row0 = u.pm * BM + wr * 64 + fr, col0 = pn * BM + wc * 32 + 8 * fq;
#pragma unroll
        for (int ai = 0; ai < 2; ++ai)
#pragma unroll
            for (int m = 0; m < 4; ++m) {
                const int pos = (wc & 1) ? (16 * m + fr) : ((t0 >> 6) + 2 * ai + wr);
                const LAS f32x2* tab = rope + pos * 16 + 8 * (fq & 1);
                bf16_t* rowp = Z + (size_t)(row0 + ai * HALF + m * 16) * ZW + col0;
                float sq = 0.f;
#pragma unroll
                for (int bj = 0; bj < 2; ++bj) {
                    f32x4 v0 = acc[ai][bj][m][0], v1 = acc[ai][bj][m][1];
                    if (dorope) rope8(v0, v1, tab, fq);
                    v0 = v0 * sc; v1 = v1 * sc;
                    if (statt) { const f32x4 q0 = v0 * v0, q1 = v1 * v1; sq += (q0[0] + q0[1]) + (q0[2] + q0[3]) + (q1[0] + q1[1]) + (q1[2] + q1[3]); }
                    store8(rowp + bj * HALF, v0, v1);
                }
                if (statt) { sq += __shfl_xor(sq, 16); sq += __shfl_xor(sq, 32);
                    if (fq == 0) atomicAdd((pn == 14 ? ssq_kv : ssq_q) + row0 + ai * HALF + m * 16, sq); }
            }
    }
};
struct EpiMq {
    static constexpr bool PERM = true;
    bf16_t* MQ; const LAS f32x2* rope; const float* rstd;
    __device__ __forceinline__ void operator()(const Acc& acc, const Unit& u, int wr, int wc, int fr, int fq) const {
        const int pn = u.pn, pmb = u.pm % 33;
        const int t0 = (pmb - 1) * 256;
        const int row0 = u.pm * BM + wr * 64 + fr, col0 = pn * BM + wc * 32 + 8 * fq;
#pragma unroll
        for (int ai = 0; ai < 2; ++ai) {
#pragma unroll
            for (int m = 0; m < 4; ++m) {
                const int row = row0 + ai * HALF + m * 16;
                const float rs = C_MLA / sqrtf(rstd[row] * (1.f / 512.f) + EPS);
                bf16_t* rowp = MQ + (size_t)row * MQW + col0;
#pragma unroll
                for (int bj = 0; bj < 2; ++bj) {
                    const int gm = (8 * pn + 4 * bj + wc) % 6;
                    f32x4 v0 = acc[ai][bj][m][0], v1 = acc[ai][bj][m][1];
                    if (gm >= 4) {
                        const int pos = (gm == 5) ? (16 * m + fr) : ((t0 >> 6) + 2 * ai + wr);
                        rope8(v0, v1, rope + pos * 16 + 8 * (fq & 1), fq);
                    }
                    v0 = v0 * rs; v1 = v1 * rs;
                    store8(rowp + bj * HALF, v0, v1);
                }
            }
            asm volatile("" ::: "memory");
        }
    }
};
struct EpiKv {
    static constexpr bool PERM = true;
    bf16_t* KV; const float* rstd;
    __device__ __forceinline__ void operator()(const Acc& acc, const Unit& u, int wr, int wc, int fr, int fq) const {
        const int row0 = u.pm * BM + wr * 64 + fr, col0 = u.pn * BM + wc * 32 + 8 * fq;
#pragma unroll
        for (int ai = 0; ai < 2; ++ai)
#pragma unroll
            for (int m = 0; m < 4; ++m) {
                const int row = row0 + ai * HALF + m * 16;
                const float rs = 1.0f / sqrtf(rstd[row] * (1.f / 256.f) + EPS);
                bf16_t* rowp = KV + (size_t)row * KVW + col0;
#pragma unroll
                for (int bj = 0; bj < 2; ++bj) store8(rowp + bj * HALF, acc[ai][bj][m][0] * rs, acc[ai][bj][m][1] * rs);
            }
    }
};
template <bool ADD> struct EpiMerge {
    static constexpr bool PERM = true;
    bf16_t* Y; const bf16_t* G;
    __device__ __forceinline__ void operator()(const Acc& acc, const Unit& u, int wr, int wc, int fr, int fq) const {
        const int row0 = u.pm * BM + wr * 64 + fr, col0 = u.pn * BM + wc * 32 + 8 * fq;
#pragma unroll
        for (int ai = 0; ai < 2; ++ai)
#pragma unroll
        for (int mh = 0; mh < 2; ++mh) {
            u32x4 gw[2][2], yw[2][2];
#pragma unroll
            for (int mm = 0; mm < 2; ++mm) { const int row = row0 + ai * HALF + (2 * mh + mm) * 16;
#pragma unroll
                for (int bj = 0; bj < 2; ++bj) { gw[mm][bj] = *(const u32x4*)(G + (size_t)row * ZW + col0 + bj * HALF);
                    if (ADD) yw[mm][bj] = *(const u32x4*)(Y + (size_t)row * DM + col0 + bj * HALF); } }
            asm volatile("" ::: "memory");
#pragma unroll
            for (int mm = 0; mm < 2; ++mm) { const int m = 2 * mh + mm; const int row = row0 + ai * HALF + m * 16;
                bf16_t* yp = Y + (size_t)row * DM + col0;
#pragma unroll
                for (int bj = 0; bj < 2; ++bj) {
                    const u32x4 g4 = gw[mm][bj];
                    f32x4 s0 = {sigmoidf_(bf_lo(g4.x)), sigmoidf_(bf_hi(g4.x)), sigmoidf_(bf_lo(g4.y)), sigmoidf_(bf_hi(g4.y))};
                    f32x4 s1 = {sigmoidf_(bf_lo(g4.z)), sigmoidf_(bf_hi(g4.z)), sigmoidf_(bf_lo(g4.w)), sigmoidf_(bf_hi(g4.w))};
                    f32x4 v0 = acc[ai][bj][m][0] * s0, v1 = acc[ai][bj][m][1] * s1;
                    if (ADD) { const u32x4 y4 = yw[mm][bj];
                        v0 += (f32x4){bf_lo(y4.x), bf_hi(y4.x), bf_lo(y4.y), bf_hi(y4.y)}; v1 += (f32x4){bf_lo(y4.z), bf_hi(y4.z), bf_lo(y4.w), bf_hi(y4.w)}; }
                    store8(yp + bj * HALF, v0, v1);
                } }
            asm volatile("" ::: "memory");
        }
    }
};
struct EpiRes {
    static constexpr bool PERM = false;
    const float* base; float* out; const float* mod; const float* bada; int goff;
    __device__ __forceinline__ void operator()(const Acc& acc, const Unit& u, int wr, int wc, int fr, int fq) const {
        const int row0 = u.pm * BM + wr * 64 + fr, col0 = u.pn * BM + wc * 32 + 4 * fq;
        const int b = (u.pm >= 33) ? 1 : 0;
        f32x4 gv[2][2];
#pragma unroll
        for (int bj = 0; bj < 2; ++bj)
#pragma unroll
            for (int n = 0; n < 2; ++n) gv[bj][n] = *(const f32x4*)(mod + b * MODW + goff + col0 + bj * HALF + 16 * n) + *(const f32x4*)(bada + goff + col0 + bj * HALF + 16 * n);
#pragma unroll
        for (int ai = 0; ai < 2; ++ai)
#pragma unroll
        for (int mh = 0; mh < 2; ++mh) {
            f32x4 bs[2][2][2];
#pragma unroll
            for (int mm = 0; mm < 2; ++mm) { const int m = 2 * mh + mm; const size_t off = (size_t)r_to_l(row0 + ai * HALF + m * 16) * DM + col0;
#pragma unroll
                for (int bj = 0; bj < 2; ++bj)
#pragma unroll
                    for (int n = 0; n < 2; ++n) bs[mm][bj][n] = *(const f32x4*)(base + off + bj * HALF + 16 * n); }
            asm volatile("" ::: "memory");
#pragma unroll
            for (int mm = 0; mm < 2; ++mm) { const int m = 2 * mh + mm; const size_t off = (size_t)r_to_l(row0 + ai * HALF + m * 16) * DM + col0;
#pragma unroll
                for (int bj = 0; bj < 2; ++bj)
#pragma unroll
                    for (int n = 0; n < 2; ++n) *(f32x4*)(out + off + bj * HALF + 16 * n) = bs[mm][bj][n] + gv[bj][n] * acc[ai][bj][m][n]; }
            asm volatile("" ::: "memory");
        }
    }
};
struct EpiSwiglu {
    static constexpr bool PERM = true;
    bf16_t* ACT;
    __device__ __forceinline__ void operator()(const Acc& acc, const Unit& u, int wr, int wc, int fr, int fq) const {
        const int row0 = u.pm * BM + wr * 64 + fr, col0 = u.pn * HALF + wc * 32 + 8 * fq;
#pragma unroll
        for (int ai = 0; ai < 2; ++ai)
#pragma unroll
            for (int m = 0; m < 4; ++m) {
                const int row = row0 + ai * HALF + m * 16;
                f32x4 o[2];
#pragma unroll
                for (int n = 0; n < 2; ++n) {
                    const f32x4 gt = acc[ai][0][m][n], up = acc[ai][1][m][n];
#pragma unroll
                    for (int j = 0; j < 4; ++j) o[n][j] = gt[j] * sigmoidf_(gt[j]) * up[j];
                }
                store8(ACT + (size_t)row * FF + col0, o[0], o[1]);
            }
    }
};
}

namespace att {
constexpr int NT = ROWS_B / 64;
constexpr int L_KN = 0, KN_B = 16384;
constexpr int L_KR = 32768, KR_B = 8192;
constexpr int L_V = 49152, V_B = 16384;
constexpr int L_WS = 98304;
constexpr int L_Q = 100352;
constexpr float THR = 8.f;
#define SBAR() __builtin_amdgcn_sched_barrier(0)
__device__ __forceinline__ int crow(int r, int hi) { return (r & 3) + 8 * (r >> 2) + 4 * hi; }

__device__ __forceinline__ void partialSM(f32x16& p0, f32x16& p1, float& m_reg, float& alpha) {
    float pmax = p0[0];
#pragma unroll
    for (int r = 1; r < 16; ++r) pmax = fmaxf(pmax, p0[r]);
#pragma unroll
    for (int r = 0; r < 16; ++r) pmax = fmaxf(pmax, p1[r]);
    { auto rr = __builtin_amdgcn_permlane32_swap(__float_as_uint(pmax), __float_as_uint(pmax), false, false);
      pmax = fmaxf(__uint_as_float(rr[0]), __uint_as_float(rr[1])); }
    float mn;
    if (__builtin_expect(__all(pmax - m_reg <= THR), 1)) { mn = m_reg; alpha = 1.f; }
    else { mn = fmaxf(m_reg, pmax); alpha = __builtin_amdgcn_exp2f(m_reg - mn); m_reg = mn; }
#pragma unroll
    for (int r = 0; r < 16; ++r) p0[r] = p0[r] - mn;
#pragma unroll
    for (int r = 0; r < 16; ++r) p1[r] = p1[r] - mn;
#pragma unroll
    for (int r = 0; r < 16; ++r) p0[r] = __builtin_amdgcn_exp2f(p0[r]);
}
__device__ __forceinline__ void partialSM_rel(f32x16& p0, f32x16& p1, float& m_reg, float& alpha, f32x16& negm) {
    float pmax = p0[0];
#pragma unroll
    for (int r = 1; r < 16; ++r) pmax = fmaxf(pmax, p0[r]);
#pragma unroll
    for (int r = 0; r < 16; ++r) pmax = fmaxf(pmax, p1[r]);
    { auto rr = __builtin_amdgcn_permlane32_swap(__float_as_uint(pmax), __float_as_uint(pmax), false, false);
      pmax = fmaxf(__uint_as_float(rr[0]), __uint_as_float(rr[1])); }
    if (__builtin_expect(__all(pmax <= THR), 1)) { alpha = 1.f; }
    else { const float dl = fmaxf(pmax, 0.f); m_reg += dl; alpha = __builtin_amdgcn_exp2f(-dl);
#pragma unroll
        for (int r = 0; r < 16; ++r) { p0[r] -= dl; p1[r] -= dl; }
        const float nm = -m_reg;
#pragma unroll
        for (int r = 0; r < 16; ++r) negm[r] = nm;
        asm volatile("" : "+v"(negm)); }
#pragma unroll
    for (int r = 0; r < 16; ++r) p0[r] = __builtin_amdgcn_exp2f(p0[r]);
}
__device__ __forceinline__ void finishSM(f32x16& p0, f32x16& p1, float alpha, float& l_reg, bf16x8& pa0, bf16x8& pa1, bf16x8& pa2, bf16x8& pa3) {
#pragma unroll
    for (int r = 0; r < 16; ++r) p1[r] = __builtin_amdgcn_exp2f(p1[r]);
    float ps = 0;
#pragma unroll
    for (int r = 0; r < 16; ++r) ps += p0[r];
#pragma unroll
    for (int r = 0; r < 16; ++r) ps += p1[r];
    { auto rr = __builtin_amdgcn_permlane32_swap(__float_as_uint(ps), __float_as_uint(ps), false, false);
      ps = __uint_as_float(rr[0]) + __uint_as_float(rr[1]); }
    l_reg = l_reg * alpha + ps;
#define PK4(P, BASE, OUT) do { unsigned a0 = cvt_pk_bf16(P[BASE + 0], P[BASE + 1]), a1 = cvt_pk_bf16(P[BASE + 2], P[BASE + 3]);   \
    unsigned b0 = cvt_pk_bf16(P[BASE + 4], P[BASE + 5]), b1 = cvt_pk_bf16(P[BASE + 6], P[BASE + 7]);                              \
    u32x4 w = {a0, a1, b0, b1}; OUT = __builtin_bit_cast(bf16x8, w); } while (0)
    PK4(p0, 0, pa0); PK4(p0, 8, pa1); PK4(p1, 0, pa2); PK4(p1, 8, pa3);
#undef PK4
}
template <bool NOPE>
__device__ __forceinline__ void qkt(f32x16& p0, f32x16& p1, const LAS char* Kn, const LAS char* Kr, const bf16x8* qr, const LAS char* qlds, int r32, int hi) {
    p0 = f32x16{}; p1 = f32x16{};
    if (NOPE) {
        const int x = r32 & 15;
#pragma unroll
        for (int d0 = 0; d0 < 8; ++d0) { const int ch = ((2 * d0 + hi) ^ x) << 4;
            const bf16x8 b0 = *(const LAS bf16x8*)(Kn + r32 * 256 + ch);
            const bf16x8 b1 = *(const LAS bf16x8*)(Kn + (32 + r32) * 256 + ch);
            bf16x8 q; if (d0 < 5) q = qr[d0]; else q = *(const LAS bf16x8*)(qlds + (d0 - 5) * 1024);
            p0 = __builtin_amdgcn_mfma_f32_32x32x16_bf16(b0, q, p0, 0, 0, 0);
            p1 = __builtin_amdgcn_mfma_f32_32x32x16_bf16(b1, q, p1, 0, 0, 0); }
    }
    const int f = (r32 >> 1) & 7;
#pragma unroll
    for (int d0 = 0; d0 < 4; ++d0) { const int ch = ((2 * d0 + hi) ^ f) << 4;
        const bf16x8 b0 = *(const LAS bf16x8*)(Kr + r32 * 128 + ch);
        const bf16x8 b1 = *(const LAS bf16x8*)(Kr + (32 + r32) * 128 + ch);
        bf16x8 q; if (NOPE) q = *(const LAS bf16x8*)(qlds + (3 + d0) * 1024); else q = qr[d0];
        p0 = __builtin_amdgcn_mfma_f32_32x32x16_bf16(b0, q, p0, 0, 0, 0);
        p1 = __builtin_amdgcn_mfma_f32_32x32x16_bf16(b1, q, p1, 0, 0, 0); }
}
template <bool NOPE>
__device__ __forceinline__ void qkt_pipe(f32x16& p0, f32x16& p1, const LAS char* Kn, const LAS char* Kr, const bf16x8* qr, const LAS char* qlds, int r32, int hi, const f32x16& negm) {
    constexpr int NC = NOPE ? 6 : 2;
    const int x = r32 & 15, f = (r32 >> 1) & 7;
    const LAS char* kn0 = Kn + r32 * 256; const LAS char* kr0 = Kr + r32 * 128;
    bf16x8 ka[4], kb[4], qa[2], qb[2];
#define LOADC(k, q, c) do { _Pragma("unroll") for (int i_ = 0; i_ < 2; ++i_) { const int d0 = 2 * (c) + i_; \
        if (NOPE && d0 < 8) { const int ch = ((2 * d0 + hi) ^ x) << 4; k[2 * i_] = *(const LAS bf16x8*)(kn0 + ch); k[2 * i_ + 1] = *(const LAS bf16x8*)(kn0 + 32 * 256 + ch); } \
        else { const int dr = d0 - (NOPE ? 8 : 0); const int ch = ((2 * dr + hi) ^ f) << 4; k[2 * i_] = *(const LAS bf16x8*)(kr0 + ch); k[2 * i_ + 1] = *(const LAS bf16x8*)(kr0 + 32 * 128 + ch); } \
        if (NOPE) { if (d0 < 5) q[i_] = qr[d0]; else q[i_] = *(const LAS bf16x8*)(qlds + (d0 - 5) * 1024); } else q[i_] = qr[d0]; } } while (0)
#define MMAC(k, q) do { _Pragma("unroll") for (int i_ = 0; i_ < 2; ++i_) { \
        p0 = __builtin_amdgcn_mfma_f32_32x32x16_bf16(k[2 * i_], q[i_], p0, 0, 0, 0); p1 = __builtin_amdgcn_mfma_f32_32x32x16_bf16(k[2 * i_ + 1], q[i_], p1, 0, 0, 0); } } while (0)
    LOADC(ka, qa, 0); LOADC(kb, qb, 1); SBAR();
    if (NOPE) { p0 = f32x16{}; p1 = f32x16{}; p0 = __builtin_amdgcn_mfma_f32_32x32x16_bf16(ka[0], qa[0], p0, 0, 0, 0); p1 = __builtin_amdgcn_mfma_f32_32x32x16_bf16(ka[1], qa[0], p1, 0, 0, 0); }
    else { p0 = __builtin_amdgcn_mfma_f32_32x32x16_bf16(ka[0], qa[0], negm, 0, 0, 0); p1 = __builtin_amdgcn_mfma_f32_32x32x16_bf16(ka[1], qa[0], negm, 0, 0, 0); }
    p0 = __builtin_amdgcn_mfma_f32_32x32x16_bf16(ka[2], qa[1], p0, 0, 0, 0); p1 = __builtin_amdgcn_mfma_f32_32x32x16_bf16(ka[3], qa[1], p1, 0, 0, 0); SBAR();
    if (NC > 2) {
        LOADC(ka, qa, 2); SBAR(); MMAC(kb, qb); SBAR();
        LOADC(kb, qb, 3); SBAR(); MMAC(ka, qa); SBAR();
        LOADC(ka, qa, 4); SBAR(); MMAC(kb, qb); SBAR();
        LOADC(kb, qb, 5); SBAR(); MMAC(ka, qa); SBAR();
        MMAC(kb, qb); SBAR();
    } else {
        MMAC(kb, qb); SBAR();
    }
#undef LOADC
#undef MMAC
}
__device__ __forceinline__ int v_st(int k, int c) { const int kk = (k & ~0xC) | ((k & 4) << 1) | ((k & 8) >> 1); return ((kk >> 3) * 4 + (c >> 5)) * 512 + ((kk & 7) * 32 + (c & 31)) * 2; }
__device__ __forceinline__ int v_rd_base(int lane) { return ((lane & 3) << 3) | (((lane >> 2) & 3) << 6) | (((lane >> 4) & 1) << 5) | (((lane >> 5) & 1) << 8); }
constexpr int v_rd_off(int d0, int ks, int half) { return d0 * 512 + ks * 4096 + half * 2048; }
template <int OFF> __device__ __forceinline__ s16x4 tr_read(int vb) {
    s16x4 r; asm volatile("ds_read_b64_tr_b16 %0, %1 offset:%2" : "=&v"(r) : "v"(vb), "i"(OFF) : "memory"); return r;
}
template <int D0> __device__ __forceinline__ void pv_one(f32x16& od, int vb, bf16x8 pa0, bf16x8 pa1, bf16x8 pa2, bf16x8 pa3) {
    const s16x4 l0 = tr_read<v_rd_off(D0, 0, 0)>(vb), h0 = tr_read<v_rd_off(D0, 0, 1)>(vb), l1 = tr_read<v_rd_off(D0, 1, 0)>(vb), h1 = tr_read<v_rd_off(D0, 1, 1)>(vb);
    const s16x4 l2 = tr_read<v_rd_off(D0, 2, 0)>(vb), h2 = tr_read<v_rd_off(D0, 2, 1)>(vb), l3 = tr_read<v_rd_off(D0, 3, 0)>(vb), h3 = tr_read<v_rd_off(D0, 3, 1)>(vb);
    asm volatile("s_waitcnt lgkmcnt(0)" ::: "memory"); SBAR();
#define PK(L, H) (bf16x8){L[0], L[1], L[2], L[3], H[0], H[1], H[2], H[3]}
    od = __builtin_amdgcn_mfma_f32_32x32x16_bf16(pa0, PK(l0, h0), od, 0, 0, 0);
    od = __builtin_amdgcn_mfma_f32_32x32x16_bf16(pa1, PK(l1, h1), od, 0, 0, 0);
    od = __builtin_amdgcn_mfma_f32_32x32x16_bf16(pa2, PK(l2, h2), od, 0, 0, 0);
    od = __builtin_amdgcn_mfma_f32_32x32x16_bf16(pa3, PK(l3, h3), od, 0, 0, 0);
#undef PK
}
__device__ __forceinline__ void pv_d0(f32x16* o, int vb, bf16x8 pa0, bf16x8 pa1, bf16x8 pa2, bf16x8 pa3) {
    pv_one<0>(o[0], vb, pa0, pa1, pa2, pa3); pv_one<1>(o[1], vb, pa0, pa1, pa2, pa3); pv_one<2>(o[2], vb, pa0, pa1, pa2, pa3); pv_one<3>(o[3], vb, pa0, pa1, pa2, pa3);
}

template <bool NOPE, int ldkn, int ldkr, int ldv, bool TWO>
__device__ __forceinline__ void attn_pass(LAS char* lds, const bf16_t* Qw, const bf16_t* Kn, const bf16_t* Kr, const bf16_t* V, f32x16 (&o)[4]) {
    int tid_ = threadIdx.x; asm volatile("" : "+v"(tid_));
    const int tid = tid_, lane = tid & 63, r32 = lane & 31, hi = lane >> 5; const int wid = __builtin_amdgcn_readfirstlane(tid >> 6);
    LAS float* ws = (LAS float*)(lds + L_WS) + wid * 64; LAS float* li_l = ws; LAS float* al_l = ws + 32;
    constexpr int NQ = NOPE ? 5 : 4;
    bf16x8 qr[NQ];
#pragma unroll
    for (int d0 = 0; d0 < NQ; ++d0) qr[d0] = *(const bf16x8*)(Qw + d0 * 16);
    const LAS char* qlds = lds + L_Q + wid * 7168 + lane * 16;
    if (NOPE) {
#pragma unroll
        for (int d0 = 0; d0 < 7; ++d0) *(LAS bf16x8*)(lds + L_Q + wid * 7168 + lane * 16 + d0 * 1024) = *(const bf16x8*)(Qw + (5 + d0) * 16);
    }
    unsigned okn0 = 0, okn1 = 0;
    if (NOPE) {
        { const int b = (wid * 2) * 1024 + lane * 16, row = b >> 8, ch = ((b & 255) >> 4) ^ (row & 15); okn0 = (unsigned)(row * ldkn + ch * 8) * 2u; }
        { const int b = (wid * 2 + 1) * 1024 + lane * 16, row = b >> 8, ch = ((b & 255) >> 4) ^ (row & 15); okn1 = (unsigned)(row * ldkn + ch * 8) * 2u; }
    }
    unsigned okr; { const int b = wid * 1024 + lane * 16, row = b >> 7, ch = ((b & 127) >> 4) ^ ((row >> 1) & 7); okr = (unsigned)(row * ldkr + ch * 8) * 2u; }
    unsigned ov0, ov1;
    { const int off = (wid * 2) * 1024 + lane * 16, sub = off >> 9, w = (off & 511) >> 1, kk = (sub >> 2) * 8 + (w >> 5), k = kk  , c = (sub & 3) * 32 + (w & 31);
      ov0 = (unsigned)(k * ldv + c) * 2u; }
    { const int off = (wid * 2 + 1) * 1024 + lane * 16, sub = off >> 9, w = (off & 511) >> 1, kk = (sub >> 2) * 8 + (w >> 5), k = kk  , c = (sub & 3) * 32 + (w & 31);
      ov1 = (unsigned)(k * ldv + c) * 2u; }
    const char* bkn = (const char*)Kn; const char* bkr = (const char*)Kr; const char* bv = (const char*)V;
    const size_t kn_step = (size_t)64 * ldkn * 2, kr_step = (size_t)64 * ldkr * 2, v_step = (size_t)64 * ldv * 2;
    const unsigned wo1 = (unsigned)wid * 1024u, wo2 = (unsigned)wid * 2048u;
#define GLDS(src, dstoff) __builtin_amdgcn_global_load_lds((const unsigned*)(src), (LAS unsigned*)(lds + (dstoff)), 16, 0, 0)
#define DMA_TILE(kb, vslot) do { \
    if (NOPE) { GLDS(bkn + okn0, L_KN + (kb) * KN_B + wo2); GLDS(bkn + okn1, L_KN + (kb) * KN_B + wo2 + 1024u); bkn += kn_step; } \
    GLDS(bkr + okr, L_KR + (kb) * KR_B + wo1); bkr += kr_step; \
    GLDS(bv + ov0, L_V + (vslot) + wo2); GLDS(bv + ov1, L_V + (vslot) + wo2 + 1024u); bv += v_step; } while (0)
    constexpr int PF_AHEAD = 3;
    const char* pfp = nullptr;
    if (!NOPE) { const int li = tid % 192; pfp = (li < 64) ? (const char*)(Kr + (size_t)li * ldkr) : (const char*)(V + (size_t)((li - 64) >> 1) * ldv + ((li - 64) & 1) * 64);
                 pfp += (size_t)PF_AHEAD * kr_step; }
    int pft = PF_AHEAD;
#define PREFETCH() do { if (!NOPE) { const char* p_ = (pft < NT) ? pfp : pfp - (size_t)PF_AHEAD * kr_step; __builtin_amdgcn_global_load_lds((const unsigned*)p_, (LAS unsigned*)(lds + L_Q + wid * 256), 4, 0, 0); pfp += kr_step; ++pft; } } while (0)
#define WAITSYNC() do { asm volatile("s_waitcnt vmcnt(0)" ::: "memory"); __syncthreads(); } while (0)
#define RESC(a) do { if (__any((a) < 1.f)) { if (hi == 0) al_l[r32] = (a); asm volatile("s_waitcnt lgkmcnt(0)" ::: "memory"); \
    _Pragma("unroll") for (int d = 0; d < 4; ++d) _Pragma("unroll") for (int r = 0; r < 16; ++r) o[d][r] *= al_l[crow(r, hi)]; } } while (0)
    const LAS char* Kn0 = lds + L_KN; const LAS char* Kn1 = lds + L_KN + KN_B; const LAS char* Kr0 = lds + L_KR; const LAS char* Kr1 = lds + L_KR + KR_B;
    const int vb0 = (int)(unsigned)(uintptr_t)(lds + L_V) + v_rd_base(lane);
    float m_reg = -1e30f, l_reg = 0.f;
#pragma unroll
    for (int d = 0; d < 4; ++d) o[d] = f32x16{};
    f32x16 pA0, pA1, pB0, pB1; float alA, alB; bf16x8 pa0, pa1, pa2, pa3;
    int sl_prev = 0, sl_cur = V_B, sl_next = 2 * V_B;
#define ROT() do { const int t_ = sl_prev; sl_prev = sl_cur; sl_cur = sl_next; sl_next = t_; } while (0)
    if (TWO) {
    DMA_TILE(0, 0);
    WAITSYNC();
    DMA_TILE(1, V_B);
    qkt<NOPE>(pA0, pA1, Kn0, Kr0, qr, qlds, r32, hi); partialSM(pA0, pA1, m_reg, alA);
    WAITSYNC();
    for (int j = 1; j + 1 < NT; j += 2) {
        DMA_TILE(0, sl_next);
        SBAR(); qkt<NOPE>(pB0, pB1, Kn1, Kr1, qr, qlds, r32, hi);
        finishSM(pA0, pA1, alA, l_reg, pa0, pa1, pa2, pa3); SBAR();
        pv_d0(o, vb0 + sl_prev, pa0, pa1, pa2, pa3); partialSM(pB0, pB1, m_reg, alB);
        RESC(alB);
        WAITSYNC(); ROT();
        DMA_TILE(1, sl_next);
        SBAR(); qkt<NOPE>(pA0, pA1, Kn0, Kr0, qr, qlds, r32, hi);
        finishSM(pB0, pB1, alB, l_reg, pa0, pa1, pa2, pa3); SBAR();
        pv_d0(o, vb0 + sl_prev, pa0, pa1, pa2, pa3); partialSM(pA0, pA1, m_reg, alA);
        RESC(alA);
        WAITSYNC(); ROT();
    }
    SBAR(); qkt<NOPE>(pB0, pB1, Kn1, Kr1, qr, qlds, r32, hi);
    finishSM(pA0, pA1, alA, l_reg, pa0, pa1, pa2, pa3); SBAR();
    pv_d0(o, vb0 + sl_prev, pa0, pa1, pa2, pa3); partialSM(pB0, pB1, m_reg, alB);
    RESC(alB);
    finishSM(pB0, pB1, alB, l_reg, pa0, pa1, pa2, pa3); SBAR();
    pv_d0(o, vb0 + sl_cur, pa0, pa1, pa2, pa3);
    } else {
        const int grp = wid >> 2;
#define BAR() __builtin_amdgcn_s_barrier()
#define VMW() do { if (NOPE) asm volatile("s_waitcnt vmcnt(0)" ::: "memory"); else asm volatile("s_waitcnt vmcnt(1)" ::: "memory"); } while (0)
#define SMB0() do { partialSM(pA0, pA1, m_reg, alA); RESC(alA); finishSM(pA0, pA1, alA, l_reg, pa0, pa1, pa2, pa3); } while (0)
#define SMB() do { if (NOPE) partialSM(pA0, pA1, m_reg, alA); else partialSM_rel(pA0, pA1, m_reg, alA, negm); RESC(alA); finishSM(pA0, pA1, alA, l_reg, pa0, pa1, pa2, pa3); } while (0)
        s16x4 va[8], vbq[8]; f32x16 negm = f32x16{};
#define VLD(dst, D0, vb) do { dst[0] = tr_read<v_rd_off(D0, 0, 0)>(vb); dst[1] = tr_read<v_rd_off(D0, 0, 1)>(vb); dst[2] = tr_read<v_rd_off(D0, 1, 0)>(vb); dst[3] = tr_read<v_rd_off(D0, 1, 1)>(vb); \
                               dst[4] = tr_read<v_rd_off(D0, 2, 0)>(vb); dst[5] = tr_read<v_rd_off(D0, 2, 1)>(vb); dst[6] = tr_read<v_rd_off(D0, 3, 0)>(vb); dst[7] = tr_read<v_rd_off(D0, 3, 1)>(vb); } while (0)
#define PKV(L, H) (bf16x8){L[0], L[1], L[2], L[3], H[0], H[1], H[2], H[3]}
#define VMM(od, src) do { od = __builtin_amdgcn_mfma_f32_32x32x16_bf16(pa0, PKV(src[0], src[1]), od, 0, 0, 0); od = __builtin_amdgcn_mfma_f32_32x32x16_bf16(pa1, PKV(src[2], src[3]), od, 0, 0, 0); \
                           od = __builtin_amdgcn_mfma_f32_32x32x16_bf16(pa2, PKV(src[4], src[5]), od, 0, 0, 0); od = __builtin_amdgcn_mfma_f32_32x32x16_bf16(pa3, PKV(src[6], src[7]), od, 0, 0, 0); } while (0)
#define LGK(n) asm volatile("s_waitcnt lgkmcnt(" #n ")" ::: "memory")
#define MBLOCK(KN, KR, vslot) do { const int vb_ = vb0 + (vslot); if (!NOPE) { VLD(va, 0, vb_); SBAR(); } \
            qkt_pipe<NOPE>(pA0, pA1, KN, KR, qr, qlds, r32, hi, negm); SBAR(); if (NOPE) { VLD(va, 0, vb_); SBAR(); } \
            VLD(vbq, 1, vb_); LGK(8); SBAR(); VMM(o[0], va); SBAR(); \
            VLD(va, 2, vb_); LGK(8); SBAR(); VMM(o[1], vbq); SBAR(); \
            VLD(vbq, 3, vb_); LGK(8); SBAR(); VMM(o[2], va); SBAR(); \
            LGK(0); SBAR(); VMM(o[3], vbq); SBAR(); } while (0)
        DMA_TILE(0, 0);
        if (grp == 1) DMA_TILE(1, V_B);
        asm volatile("s_waitcnt vmcnt(0)" ::: "memory"); __syncthreads();
        if (grp == 1) { __builtin_amdgcn_s_setprio(1); BAR(); }
        SBAR(); qkt<NOPE>(pA0, pA1, Kn0, Kr0, qr, qlds, r32, hi); SBAR();
        if (grp == 0) { DMA_TILE(1, V_B); PREFETCH(); }
        if (grp == 1) VMW();
        BAR();
        if (grp == 1) { DMA_TILE(0, 2 * V_B); PREFETCH(); }
        SMB0();
        if (!NOPE) { const float nm = -m_reg;
#pragma unroll
          for (int r = 0; r < 16; ++r) negm[r] = nm;
          asm volatile("" : "+v"(negm)); }
        if (grp == 0) VMW();
        BAR();
        int s0 = 0, s1 = V_B, s2 = 2 * V_B;
#define ROT3() do { const int t_ = s0; s0 = s1; s1 = s2; s2 = t_; } while (0)
        for (int j = 1; j + 1 < NT; j += 2) {
            MBLOCK(Kn1, Kr1, s0);
            if (grp == 1) VMW();
            BAR();
            if (grp == 0) { DMA_TILE(0, s2); PREFETCH(); }
            if (grp == 1) { DMA_TILE(1, s0); PREFETCH(); }
            SMB();
            if (grp == 0) VMW();
            BAR();
            ROT3();
            MBLOCK(Kn0, Kr0, s0);
            if (grp == 1) VMW();
            BAR();
            if (grp == 0) { DMA_TILE(1, s2); PREFETCH(); }
            if (grp == 1 && j + 3 < NT) { DMA_TILE(0, s0); PREFETCH(); }
            SMB();
            if (grp == 0) VMW();
            BAR();
            ROT3();
        }
        MBLOCK(Kn1, Kr1, s0);
        if (grp == 1) VMW();
        BAR();
        SMB();
        BAR();
        ROT3();
        { const int vb_ = vb0 + s0; VLD(va, 0, vb_); VLD(vbq, 1, vb_); LGK(8); SBAR(); VMM(o[0], va); SBAR();
          VLD(va, 2, vb_); LGK(8); SBAR(); VMM(o[1], vbq); SBAR();
          VLD(vbq, 3, vb_); LGK(8); SBAR(); VMM(o[2], va); SBAR();
          LGK(0); SBAR(); VMM(o[3], vbq); SBAR(); }
        if (grp == 0) BAR();
        __builtin_amdgcn_s_setprio(0);
#undef BAR
#undef VMW
#undef SMB
#undef SMB0
#undef VLD
#undef PKV
#undef VMM
#undef LGK
#undef MBLOCK
#undef ROT3
    }
    if (hi == 0) li_l[r32] = l_reg; asm volatile("s_waitcnt lgkmcnt(0)" ::: "memory");
#pragma unroll
    for (int r = 0; r < 16; ++r) { const float rl = __builtin_amdgcn_rcpf(li_l[crow(r, hi)]);
#pragma unroll
        for (int d = 0; d < 4; ++d) o[d][r] *= rl; }
    asm volatile("s_waitcnt vmcnt(0)" ::: "memory");
    __syncthreads();
#undef GLDS
#undef DMA_TILE
#undef WAITSYNC
#undef PREFETCH
#undef RESC
#undef ROT
}
#undef SBAR
}

#define XB_TMO      128
#define XB_XCNT(j)  (256  + 64 * (j))
#define XB_XSUB(j)  (1280 + 64 * (j))
#define XB_XGEN(j)  (2304 + 64 * (j))
#define XB_TOP      3328
#define XB_TOPGEN   3392
#define XCD_BAR_WORDS 3456
#define XB_SPIN_CAP (1u << 18)

__device__ __forceinline__ unsigned xb_ld(unsigned* p)              { return __hip_atomic_load(p, __ATOMIC_RELAXED, __HIP_MEMORY_SCOPE_AGENT); }
__device__ __forceinline__ unsigned xb_add(unsigned* p, unsigned v) { return __hip_atomic_fetch_add(p, v, __ATOMIC_RELAXED, __HIP_MEMORY_SCOPE_AGENT); }
__device__ __forceinline__ unsigned xb_xcc_id() { return (unsigned)__builtin_amdgcn_s_getreg((3 << 11) | 20) & 0xFu; }
#define XB_SPIN(cond, bar) do { unsigned _sp = 0; while (cond) { __builtin_amdgcn_s_sleep(1); \
    if ((++_sp & 255u) == 0u) { if (xb_ld(&(bar)[XB_TMO])) break; if (_sp > XB_SPIN_CAP) { atomicAdd(&(bar)[XB_TMO], 1u); break; } } } } while (0)

struct XcdBarrier {
    unsigned* bar; unsigned x;
    volatile LAS unsigned* st;
};

__device__ __forceinline__ XcdBarrier xcd_barrier_post(unsigned* bar, volatile LAS unsigned* st) {
    XcdBarrier b; b.bar = bar; b.x = xb_xcc_id(); b.st = st;
    if (threadIdx.x == 0) (void)xb_add(&bar[XB_XCNT(b.x)], 1u);
    return b;
}
__device__ __forceinline__ void xcd_barrier_complete(unsigned* bar, unsigned x, unsigned& nloc, unsigned& nx) {
    const unsigned G = gridDim.x * gridDim.y * gridDim.z;
    unsigned sum, cnt, mine, sp = 0u;
    for (;;) {
        sum = 0u; cnt = 0u; mine = 0u;
#pragma unroll
        for (unsigned j = 0; j < 16; ++j) { const unsigned c = xb_ld(&bar[XB_XCNT(j)]); sum += c; cnt += (c > 0u) ? 1u : 0u; mine = (j == x) ? c : mine; }
        if (sum == G) break;
        __builtin_amdgcn_s_sleep(1);
        if ((++sp & 255u) == 0u) { if (xb_ld(&bar[XB_TMO])) break; if (sp > XB_SPIN_CAP) { atomicAdd(&bar[XB_TMO], 1u); break; } }
    }
    nloc = mine > 0u ? mine : 1u; nx = cnt > 0u ? cnt : 1u;
}

__device__ __forceinline__ void xcd_barrier(const XcdBarrier& b) {
    asm volatile("s_waitcnt vmcnt(0)" ::: "memory");
    __syncthreads();
    if (threadIdx.x == 0) {
        unsigned* bar = b.bar;
        __builtin_amdgcn_s_waitcnt(0);
        unsigned nloc = b.st[0], nx = b.st[1];
        if (nloc == 0u) { xcd_barrier_complete(bar, b.x, nloc, nx); b.st[0] = nloc; b.st[1] = nx; }
        const unsigned old = xb_add(&bar[XB_XSUB(b.x)], 1u);
        const unsigned gen = old / nloc;
        if (old + 1u == (gen + 1u) * nloc) {
            __builtin_amdgcn_fence(__ATOMIC_RELEASE, "agent");
            asm volatile("s_waitcnt vmcnt(0)" ::: "memory");
            const unsigned og = xb_add(&bar[XB_TOP], 1u);
            const unsigned tg = og / nx;
            if (og + 1u == (tg + 1u) * nx) xb_add(&bar[XB_TOPGEN], 1u);
            else XB_SPIN(xb_ld(&bar[XB_TOPGEN]) == tg, bar);
            __builtin_amdgcn_fence(__ATOMIC_ACQUIRE, "agent");
            xb_add(&bar[XB_XGEN(b.x)], 1u);
            asm volatile("s_waitcnt vmcnt(0)" ::: "memory");
        } else {
            XB_SPIN(xb_ld(&bar[XB_XGEN(b.x)]) == gen, bar);
            __builtin_amdgcn_fence(__ATOMIC_ACQUIRE, "agent");
            asm volatile("s_waitcnt vmcnt(0)" ::: "memory");
        }
    }
    __syncthreads();
}


constexpr int N_PHASES_K = 12;
struct Args { const float* in[22]; float* out; unsigned char* ws; int ph_lo, ph_hi; };

__device__ __forceinline__ void p0_tr_item(const float* W, int K, int N, int k0, int n0, bf16_t* WT, int drow0, const float* gk, LAS float* scr, int lane) {
    float v_[32];
#pragma unroll
    for (int i = 0; i < 32; ++i) { const int kk = 2 * i + (lane >> 5); v_[i] = W[(size_t)(k0 + kk) * N + n0 + (lane & 31)]; }
#pragma unroll
    for (int i = 0; i < 32; ++i) { const int kk = 2 * i + (lane >> 5); float v = v_[i]; if (gk) v *= gk[k0 + kk]; scr[kk * 33 + (lane & 31)] = v; }
    asm volatile("s_waitcnt lgkmcnt(0)" ::: "memory");
    const int c = lane & 7;
#pragma unroll
    for (int j = 0; j < 4; ++j) { const int n = (lane >> 3) + 8 * j; const LAS float* s = scr + (8 * c) * 33 + n;
        u32x4 o; o.x = cvt_pk_bf16(s[0 * 33], s[1 * 33]); o.y = cvt_pk_bf16(s[2 * 33], s[3 * 33]); o.z = cvt_pk_bf16(s[4 * 33], s[5 * 33]); o.w = cvt_pk_bf16(s[6 * 33], s[7 * 33]);
        *(u32x4*)(WT + (size_t)(drow0 + n) * K + k0 + 8 * c) = o; }
    asm volatile("s_waitcnt lgkmcnt(0)" ::: "memory");
}

template <int MODE>
__device__ __forceinline__ void norm_row(const float* xrow, const float* g, const float* mod_s, const float* bada, int shoff, int scoff, void* orow, int lane) {
    const f32x4* xr = (const f32x4*)xrow + lane;
    f32x4 v[8]; float s2 = 0.f;
#pragma unroll
    for (int j = 0; j < 8; ++j) { v[j] = xr[64 * j]; s2 += (v[j].x * v[j].x + v[j].y * v[j].y) + (v[j].z * v[j].z + v[j].w * v[j].w); }
    const float rstd = 1.0f / sqrtf(wave_sum(s2) * (1.f / DM) + EPS);
#pragma unroll
    for (int j = 0; j < 8; ++j) {
        const int c = (lane + 64 * j) * 4;
        const f32x4 gg = *(const f32x4*)(g + c);
        f32x4 y = v[j] * rstd * gg;
        if (MODE == 0) {
            const f32x4 sh = *(const f32x4*)(mod_s + shoff + c) + *(const f32x4*)(bada + shoff + c);
            const f32x4 sc = *(const f32x4*)(mod_s + scoff + c) + *(const f32x4*)(bada + scoff + c);
            y = y * (sc + 1.0f) + sh;
            u32x2 w; w.x = cvt_pk_bf16(y.x, y.y); w.y = cvt_pk_bf16(y.z, y.w);
            *((u32x2*)orow + lane + 64 * j) = w;
        } else {
            *((f32x4*)orow + lane + 64 * j) = y;
        }
    }
}

__global__ void __launch_bounds__(NWAVES * 64, 2) mk_fwd(Args args) {
    extern __shared__ __attribute__((aligned(16))) unsigned char lds_raw[];
    LAS unsigned char* lds = (LAS unsigned char*)lds_raw;
    const int tid = threadIdx.x, lane = tid & 63, wave = __builtin_amdgcn_readfirstlane(tid >> 6);
    const int G = gridDim.x, bx = blockIdx.x;
    const int gw = bx * NWAVES + wave, NGW = G * NWAVES;
#define ws (args.ws)
#define xin (args.in[0])
#define cvec (args.in[1])
#define ctx (args.in[2])
#define c_ctx (args.in[3])
#define w_ada (args.in[4])
#define b_ada (args.in[5])
#define norm1_g (args.in[6])
#define norm2_g (args.in[7])
#define w_in (args.in[8])
#define da_lambda (args.in[9])
#define da_g (args.in[10])
#define mla_q_g (args.in[11])
#define mla_kv_g (args.in[12])
#define w_uq (args.in[13])
#define w_ukv (args.in[14])
#define w_o_da (args.in[15])
#define w_o_mla (args.in[16])
#define w_out (args.in[17])
#define w_gate (args.in[18])
#define w_up (args.in[19])
#define w_down (args.in[20])
#define final_g (args.in[21])
#define out (args.out)
#define mod ((float*)(ws + WS_MOD))
#define rope ((f32x2*)(ws + WS_ROPE))
#define rstd_q ((float*)(ws + WS_RSQ))
#define rstd_kv ((float*)(ws + WS_RSKV))
#define WinT ((bf16_t*)(ws + WS_WIN))
#define WuqT ((bf16_t*)(ws + WS_WUQ))
#define WukvT ((bf16_t*)(ws + WS_WUKV))
#define WodaT ((bf16_t*)(ws + WS_WODA))
#define WomlaT ((bf16_t*)(ws + WS_WOMLA))
#define WoutT ((bf16_t*)(ws + WS_WOUT))
#define WguT ((bf16_t*)(ws + WS_WGU))
#define WdT ((bf16_t*)(ws + WS_WD))
#define HB ((bf16_t*)(ws + WS_H))
#define Z ((bf16_t*)(ws + WS_Z))
#define MQ ((bf16_t*)(ws + WS_MQ))
#define KV HB
#define Y HB
#define H2 HB
#define ACT Z
#define stash ((float*)((unsigned char*)out + OUT_STASH))
#define OMLA ((bf16_t*)((unsigned char*)out + OUT_OMLA))
#define ODA ((bf16_t*)((unsigned char*)out + OUT_ODA))

    if (tid < 64) ((LAS unsigned*)(lds + LDS_MISC))[tid] = 0u;
    __syncthreads();
    XcdBarrier xbar = xcd_barrier_post((unsigned*)(ws + WS_BAR), (volatile LAS unsigned*)(lds + LDS_MISC));
    const int lo = args.ph_lo, hi = args.ph_hi;
#ifndef PH_MASK
#define PH_MASK 0xFFF
#endif
#define IN(k) (((PH_MASK >> (k)) & 1) && lo <= (k) && (k) < hi)
#ifndef PROBE_DUP
#define PROBE_DUP -1
#endif
#define REP(k) for (int rep_ = 0; rep_ < ((PROBE_DUP) == (k) ? 2 : 1); ++rep_)
#define SEAM(k) do { if (IN(k) && IN((k) + 1)) { if (lo < 0) cg::this_grid().sync(); xcd_barrier(xbar); } } while (0)

    if (IN(0)) REP(0) {
        LAS float* scr = (LAS float*)(lds + wave * 16384);
        constexpr int I_IN = 32 * 250, I_UQ = 8 * 48, I_UKV = 4 * 64, I_O = 16 * 64, I_OUT = 32 * 64, I_G = 32 * 176, I_D = 88 * 64;
        constexpr int I_PAD = 192, I_ROPE = 32, I_ADA = 32 * 48;
        constexpr int NITEMS = I_ADA + I_IN + I_UQ + I_UKV + 2 * I_O + I_OUT + 2 * I_G + I_D + I_PAD + I_ROPE;
        for (int it = gw; it < NITEMS; it += NGW) {
            int r = it;
            if (r < I_ADA) {
                const int kc = r / 48, cb = r % 48, n = cb * 256 + lane * 4;
                f32x4 a0 = {0, 0, 0, 0}, a1 = a0, a2 = a0;
#pragma unroll 8
                for (int kk = 0; kk < 64; ++kk) { const int k = kc * 64 + kk;
                    const f32x4 w = *(const f32x4*)(w_ada + (size_t)k * MODW + n);
                    const float c0 = cvec[k], c1 = cvec[DM + k], c2 = c_ctx[k];
                    a0 += w * (c0 * sigmoidf_(c0)); a1 += w * (c1 * sigmoidf_(c1)); a2 += w * (c2 * sigmoidf_(c2)); }
#pragma unroll
                for (int j = 0; j < 4; ++j) { atomicAdd(mod + n + j, a0[j]); atomicAdd(mod + MODW + n + j, a1[j]); atomicAdd(mod + 2 * MODW + n + j, a2[j]); }
                continue; } r -= I_ADA;
            if (r < I_IN) { const int kb = r / 250, nb = r % 250, n0 = nb * 32; p0_tr_item(w_in, DM, INW, kb * 64, n0, WinT, n0 + (n0 >= 3904 ? 192 : 0), nullptr, scr, lane); continue; } r -= I_IN;
            if (r < I_UQ) { const int kb = r / 48, nb = r % 48; p0_tr_item(w_uq, 512, MQW, kb * 64, nb * 32, WuqT, nb * 32, mla_q_g, scr, lane); continue; } r -= I_UQ;
            if (r < I_UKV) { const int kb = r / 64, nb = r % 64; p0_tr_item(w_ukv, 256, KVW, kb * 64, nb * 32, WukvT, nb * 32, mla_kv_g, scr, lane); continue; } r -= I_UKV;
            if (r < I_O) { const int kb = r / 64, nb = r % 64; p0_tr_item(w_o_da, OW, DM, kb * 64, nb * 32, WodaT, nb * 32, nullptr, scr, lane); continue; } r -= I_O;
            if (r < I_O) { const int kb = r / 64, nb = r % 64; p0_tr_item(w_o_mla, OW, DM, kb * 64, nb * 32, WomlaT, nb * 32, nullptr, scr, lane); continue; } r -= I_O;
            if (r < I_OUT) { const int kb = r / 64, nb = r % 64; p0_tr_item(w_out, DM, DM, kb * 64, nb * 32, WoutT, nb * 32, nullptr, scr, lane); continue; } r -= I_OUT;
            if (r < I_G) { const int kb = r / 176, nb = r % 176, n0 = nb * 32; p0_tr_item(w_gate, DM, FF, kb * 64, n0, WguT, (n0 >> 7) * 256 + (n0 & 127), nullptr, scr, lane); continue; } r -= I_G;
            if (r < I_G) { const int kb = r / 176, nb = r % 176, n0 = nb * 32; p0_tr_item(w_up, DM, FF, kb * 64, n0, WguT, (n0 >> 7) * 256 + 128 + (n0 & 127), nullptr, scr, lane); continue; } r -= I_G;
            if (r < I_D) { const int kb = r / 64, nb = r % 64; p0_tr_item(w_down, FF, DM, kb * 64, nb * 32, WdT, nb * 32, nullptr, scr, lane); continue; } r -= I_D;
            if (r < I_PAD) { u32x4* p = (u32x4*)(WinT + (size_t)(3904 + r) * DM) + lane; const u32x4 z = {0, 0, 0, 0};
#pragma unroll
                for (int j = 0; j < 4; ++j) p[64 * j] = z; continue; } r -= I_PAD;
            { const int e = r * 64 + lane, pos = e >> 4, i = e & 15;
              const float inv = exp2f(-(float)i * (13.287712379549449f / 16.0f)); const float a = (float)pos * inv;
              rope[e] = (f32x2){cosf(a), sinf(a)}; }
        }
    }
    SEAM(0);
    if (IN(1)) REP(1) {
        for (int r = gw; r < MR; r += NGW) {
            const int b = r / ROWS_B, rr = r % ROWS_B;
            const float* src = (rr < CTX) ? ctx + ((size_t)b * CTX + rr) * DM : xin + ((size_t)b * SEQ + (rr - CTX)) * DM;
            const int s = (rr < CTX) ? 2 : b;
            norm_row<0>(src, norm1_g, mod + s * MODW, b_ada, 0, DM, HB + (size_t)r * DM, lane);
        }
    }
    SEAM(1);
    if (IN(2)) REP(2) {
        { const u32x4* src = (const u32x4*)rope; LAS u32x4* dst = (LAS u32x4*)(lds + LDS_ROPE);
          dst[tid] = src[tid]; dst[tid + 512] = src[tid + 512]; __syncthreads(); }
        pg8::Gemm g{HB, WinT, DM, DM}; pg8::StaticOrder S; S.init(MR, ZW, G, bx, 0);
        pg8::EpiIn E{Z, (const LAS f32x2*)(lds + LDS_ROPE), rstd_q, rstd_kv};
        pg8::gemm_phase(lds, g, S, E);
    }
    SEAM(2);
    if (IN(4)) REP(4) {
        { const u32x4* src = (const u32x4*)rope; LAS u32x4* dst = (LAS u32x4*)(lds + LDS_ROPE);
          dst[tid] = src[tid]; dst[tid + 512] = src[tid + 512]; __syncthreads(); }
        { pg8::Gemm g{Z + Z_CQ, WuqT, ZW, 512}; pg8::StaticOrder S; S.init(ML, MQW, G, bx, 1);
          pg8::EpiMq E{MQ, (const LAS f32x2*)(lds + LDS_ROPE), rstd_q}; pg8::gemm_phase(lds, g, S, E); }
        { pg8::Gemm g{Z + Z_CKV, WukvT, ZW, 256}; pg8::StaticOrder S; S.init(MR, KVW, G, (bx + 128) % G, 0);
          pg8::EpiKv E{KV, rstd_kv}; pg8::gemm_phase(lds, g, S, E); }
    }
    SEAM(4);
    if (IN(5)) {
        const int r32 = lane & 31, hh = lane >> 5;
        float lam;
        { const float a = da_lambda[lane] * da_lambda[64 + lane], b2 = da_lambda[128 + lane] * da_lambda[192 + lane];
          lam = __expf(wave_sum(a)) - __expf(wave_sum(b2)) + LAM_INIT; }
        const int vcu = (G % 8 == 0) ? (bx & 7) * (G >> 3) + (bx >> 3) : bx;
#ifndef ATT_SKIP_DA
        for (int w = vcu; w < 256; w += G)
        for (int slot = 0; slot < 2; ++slot) REP(50) {
            const int pr = (w >> 5) * 2 + slot, qt = w & 31, b = pr >> 3, h = pr & 7;
            const int rowq = b * ROWS_B + CTX + qt * 256 + wave * 32;
            const bf16_t* Zb = Z + (size_t)b * ROWS_B * ZW;
            f32x16 o[4];
            float* st = stash + ((size_t)(bx * NWAVES + wave) * 64) * 64 + lane * 4;
            for (int sub = 0; sub < 2; ++sub) {
                const int sh_ = 2 * h + sub;
                att::attn_pass<false, ZW, ZW, ZW, ATT_TWO_DA>((LAS char*)lds, Z + (size_t)(rowq + r32) * ZW + Z_DQ + sh_ * 64 + hh * 8, nullptr,
                                      Zb + Z_DK + sh_ * 64, Zb + Z_DV + h * 128, o);
                if (sub == 0) {
                    f32x4* stp = (f32x4*)st; asm volatile("" : "+v"(stp));
#pragma unroll
                    for (int d = 0; d < 4; ++d)
#pragma unroll
                        for (int r = 0; r < 16; r += 4) stp[(d * 4 + (r >> 2)) * 64] = (f32x4){o[d][r], o[d][r + 1], o[d][r + 2], o[d][r + 3]};
                }
            }
            float ss[16];
#pragma unroll
            for (int r = 0; r < 16; ++r) ss[r] = 0.f;
#pragma unroll
            for (int d = 0; d < 4; ++d) {
                const f32x4* stp = (const f32x4*)st + d * 256; asm volatile("" : "+v"(stp));
#pragma unroll
                for (int r = 0; r < 16; r += 4) { const f32x4 sv = stp[(r >> 2) * 64];
#pragma unroll
                    for (int q = 0; q < 4; ++q) { const float v = sv[q] - lam * o[d][r + q]; o[d][r + q] = v; ss[r + q] += v * v; } } }
#pragma unroll
            for (int r = 0; r < 16; ++r) {
                float s = ss[r];
                s += __shfl_xor(s, 1); s += __shfl_xor(s, 2); s += __shfl_xor(s, 4); s += __shfl_xor(s, 8); s += __shfl_xor(s, 16);
                ss[r] = (1.0f - LAM_INIT) / sqrtf(s * (1.f / 128.f) + EPS);
            }
#pragma unroll
            for (int d = 0; d < 4; ++d) { const float gg = da_g[d * 32 + r32];
                bf16_t* zo = ODA + (size_t)(rowq + 4 * hh) * OW + h * 128 + d * 32 + r32; asm volatile("" : "+v"(zo));
#pragma unroll
                for (int r = 0; r < 16; ++r) {
                    const float v = o[d][r] * ss[r] * gg;
                    zo[(size_t)((r & 3) + 8 * (r >> 2)) * OW] = (bf16_t)(cvt_pk_bf16(v, v) & 0xffffu);
                } }
        }
#endif
#ifndef ATT_SKIP_MLA
        for (int w = vcu; w < 256; w += G)
        for (int slot = 0; slot < 2; ++slot) REP(51) {
            const int pr = (w >> 5) * 2 + slot, qt = w & 31, b = pr >> 3, h = pr & 7;
            const int rowq = b * ROWS_B + CTX + qt * 256 + wave * 32;
            const bf16_t* Zb = Z + (size_t)b * ROWS_B * ZW;
            f32x16 o[4];
            att::attn_pass<true, KVW, ZW, KVW, ATT_TWO_MLA>((LAS char*)lds, MQ + (size_t)(rowq + r32) * MQW + h * 192 + hh * 8,
                                 KV + (size_t)b * ROWS_B * KVW + h * 256, Zb + Z_KR, KV + (size_t)b * ROWS_B * KVW + h * 256 + 128, o);
#pragma unroll
            for (int d = 0; d < 4; ++d) {
                bf16_t* oo = OMLA + (size_t)(rowq + 4 * hh) * OW + h * 128 + d * 32 + r32; asm volatile("" : "+v"(oo));
#pragma unroll
                for (int r = 0; r < 16; ++r)
                    oo[(size_t)((r & 3) + 8 * (r >> 2)) * OW] = (bf16_t)(cvt_pk_bf16(o[d][r], o[d][r]) & 0xffffu); }
        }
#endif
    }
    SEAM(5);
    if (IN(6)) REP(6) {
        { pg8::Gemm g{ODA, WodaT, OW, OW}; pg8::StaticOrder S; S.init(ML, DM, G, bx, 1);
          pg8::EpiMerge<false> E{Y, Z + Z_GA}; pg8::gemm_phase(lds, g, S, E); }
        { pg8::Gemm g{OMLA, WomlaT, OW, OW}; pg8::StaticOrder S; S.init(ML, DM, G, bx, 1);
          pg8::EpiMerge<true> E{Y, Z + Z_GB}; pg8::gemm_phase(lds, g, S, E); }
    }
    SEAM(6);
    if (IN(7)) REP(7) {
        pg8::Gemm g{Y, WoutT, DM, DM}; pg8::StaticOrder S; S.init(ML, DM, G, bx, 1);
        pg8::EpiRes E{xin, out, mod, b_ada, 2 * DM}; pg8::gemm_phase(lds, g, S, E);
    }
    SEAM(7);
    if (IN(8)) REP(8) {
        for (int l = gw; l < ML; l += NGW) {
            const int b = l >> 13, r = l + 256 * (1 + b);
            norm_row<0>(out + (size_t)l * DM, norm2_g, mod + b * MODW, b_ada, 3 * DM, 4 * DM, H2 + (size_t)r * DM, lane);
        }
    }
    SEAM(8);
    if (IN(9)) REP(9) {
        pg8::Gemm g{H2, WguT, DM, DM}; pg8::StaticOrder S; S.init(ML, 2 * FF, G, bx, 1);
        pg8::EpiSwiglu E{ACT}; pg8::gemm_phase(lds, g, S, E);
    }
    SEAM(9);
    if (IN(10)) {
        pg8::Gemm g{ACT, WdT, FF, FF}; pg8::StaticOrder S; S.init(ML, DM, G, bx, 1);
        pg8::EpiRes E{out, out, mod, b_ada, 5 * DM}; pg8::gemm_phase(lds, g, S, E);
    }
    SEAM(10);
    if (IN(11)) {
        for (int l = gw; l < ML; l += NGW) norm_row<1>(out + (size_t)l * DM, final_g, nullptr, nullptr, 0, 0, out + (size_t)l * DM, lane);
    }
#if PROBE_DUP == 99
    if (lo == 0 && hi == N_PHASES_K) { for (int i = 0; i < 10; ++i) xcd_barrier(xbar); }
#endif
#undef IN
#undef SEAM
}

#undef ws
#undef xin
#undef cvec
#undef ctx
#undef c_ctx
#undef w_ada
#undef b_ada
#undef norm1_g
#undef norm2_g
#undef w_in
#undef da_lambda
#undef da_g
#undef mla_q_g
#undef mla_kv_g
#undef w_uq
#undef w_ukv
#undef w_o_da
#undef w_o_mla
#undef w_out
#undef w_gate
#undef w_up
#undef w_down
#undef final_g
#undef out
#undef mod
#undef rope
#undef rstd_q
#undef rstd_kv
#undef WinT
#undef WuqT
#undef WukvT
#undef WodaT
#undef WomlaT
#undef WoutT
#undef WguT
#undef WdT
#undef HB
#undef Z
#undef MQ
#undef KV
#undef Y
#undef H2
#undef ACT
#undef stash
#undef OMLA
#undef ODA
constexpr int N_PHASES = 12;

extern "C" void kernel_launch(void* const* d_in, const int* in_sizes, int n_in, void* d_out, int out_size, void* d_ws, size_t ws_size, hipStream_t stream) {
    static int grid = 0;
    if (grid == 0) {
        if (n_in != 22 || out_size != ML * DM || ws_size < WS_END) { fprintf(stderr, "kernel_launch: unexpected shapes (n_in %d out %d ws %zu)\n", n_in, out_size, ws_size); grid = -1; return; }
        int dev = 0, cus = 0, per_cu = 0;
        hipGetDevice(&dev); hipDeviceGetAttribute(&cus, hipDeviceAttributeMultiprocessorCount, dev);
        if (hipFuncSetAttribute((const void*)mk_fwd, hipFuncAttributeMaxDynamicSharedMemorySize, LDS_BYTES) != hipSuccess) { fprintf(stderr, "kernel_launch: hipFuncSetAttribute failed\n"); grid = -1; return; }
        if (hipOccupancyMaxActiveBlocksPerMultiprocessor(&per_cu, (const void*)mk_fwd, NWAVES * 64, LDS_BYTES) != hipSuccess || per_cu < 1) { fprintf(stderr, "kernel_launch: occupancy query says %d\n", per_cu); per_cu = 1; }
        (void)hipGetLastError();
        grid = cus;
        if (grid > 256) grid = 256;
    }
    if (grid < 0) return;
    (void)hipMemsetAsync((char*)d_ws + WS_MOD, 0, CTL_ZERO_BYTES, stream);
    Args a{};
    for (int i = 0; i < 22; ++i) a.in[i] = (const float*)d_in[i];
    a.out = (float*)d_out; a.ws = (unsigned char*)d_ws;
#if MK_PER_PHASE
    for (int p = 0; p < N_PHASES; ++p) { a.ph_lo = p; a.ph_hi = p + 1; hipLaunchKernelGGL(mk_fwd, dim3(grid), dim3(NWAVES * 64), LDS_BYTES, stream, a); }
#else
    a.ph_lo = 0; a.ph_hi = N_PHASES;
    void* kargs[] = {&a};
    hipError_t e = hipLaunchCooperativeKernel((const void*)mk_fwd, dim3(grid), dim3(NWAVES * 64), kargs, LDS_BYTES, stream);
    if (e != hipSuccess) fprintf(stderr, "cooperative launch failed: %s (grid %d)\n", hipGetErrorString(e), grid);
#endif
}
```

```cpp
#include <hip/hip_runtime.h>
#include <hip/hip_cooperative_groups.h>
#include <cstdio>
#include <cstdint>
namespace cg = cooperative_groups;

#define LAS __attribute__((address_space(3)))
typedef unsigned short bf16_t;
typedef short bf16x8 __attribute__((ext_vector_type(8)));
typedef short s16x4 __attribute__((ext_vector_type(4)));
typedef float f32x2 __attribute__((ext_vector_type(2)));
typedef float f32x4 __attribute__((ext_vector_type(4)));
typedef float f32x16 __attribute__((ext_vector_type(16)));
typedef unsigned u32x2 __attribute__((ext_vector_type(2)));
typedef unsigned u32x4 __attribute__((ext_vector_type(4)));

#ifndef ATT_TWO_DA
#define ATT_TWO_DA false
#endif
#ifndef ATT_TWO_MLA
#define ATT_TWO_MLA false
#endif
#ifndef MK_PER_PHASE
#define MK_PER_PHASE 0
#endif

constexpr int DM = 2048, NB = 2, SEQ = 8192, CTX = 256;
constexpr int ROWS_B = SEQ + CTX;
constexpr int MR = NB * ROWS_B;
constexpr int ML = NB * SEQ;
constexpr int ZW = 8192;
constexpr int Z_DQ = 0, Z_DK = 1024, Z_DV = 2048, Z_CQ = 3072, Z_CKV = 3584, Z_KR = 3840, Z_GA = 4096, Z_GB = 6144;
constexpr int FF = 5632, INW = 8000, MODW = 6 * DM;
constexpr int MQW = 1536, KVW = 2048, OW = 1024;
constexpr float EPS = 1e-6f;
constexpr float LOG2E = 1.4426950408889634f;
constexpr float C_DA = 0.125f * LOG2E;
constexpr float C_MLA = 0.07216878364870322f * LOG2E;
constexpr float LAM_INIT = 0.2f;

constexpr size_t MiB = 1u << 20;
constexpr size_t WS_MOD = 0;
constexpr size_t MOD_BYTES = 3 * MODW * 4;
constexpr size_t WS_BAR = 160 * 1024;
constexpr size_t WS_RSQ = 176 * 1024;
constexpr size_t WS_RSKV = 244 * 1024;
constexpr size_t CTL_ZERO_BYTES = 312 * 1024;
constexpr size_t WS_ROPE = 768 * 1024;
constexpr size_t WS_WIN = 1 * MiB;
constexpr size_t WS_WUQ = 33 * MiB;
constexpr size_t WS_WUKV = 35 * MiB;
constexpr size_t WS_WODA = 36 * MiB;
constexpr size_t WS_WOMLA = 40 * MiB;
constexpr size_t WS_WOUT = 44 * MiB;
constexpr size_t WS_WGU = 52 * MiB;
constexpr size_t WS_WD = 96 * MiB;
constexpr size_t WS_H = 118 * MiB;
constexpr size_t WS_Z = 184 * MiB;
constexpr size_t WS_MQ = 448 * MiB;
constexpr size_t WS_END = 498 * MiB;
constexpr size_t OUT_STASH = 0;
constexpr size_t OUT_OMLA = 32 * MiB;
constexpr size_t OUT_ODA = 66 * MiB;

constexpr int NWAVES = 8;
constexpr int LDS_ROPE = 131072;
constexpr int LDS_MISC = 154 * 1024;
constexpr int LDS_BYTES = 154 * 1024 + 256;

__device__ __forceinline__ unsigned cvt_pk_bf16(float lo, float hi) { unsigned r; asm volatile("v_cvt_pk_bf16_f32 %0, %1, %2" : "=v"(r) : "v"(lo), "v"(hi)); return r; }
__device__ __forceinline__ float bf_lo(unsigned w) { return __uint_as_float(w << 16); }
__device__ __forceinline__ float bf_hi(unsigned w) { return __uint_as_float(w & 0xffff0000u); }
__device__ __forceinline__ float wave_sum(float v) {
#pragma unroll
    for (int o = 1; o < 64; o <<= 1) v += __shfl_xor(v, o);
    return v;
}
__device__ __forceinline__ float sigmoidf_(float x) { return __builtin_amdgcn_rcpf(1.0f + __expf(-x)); }
__device__ __forceinline__ int r_to_l(int r) { return r - 256 * (1 + (r >= ROWS_B ? 1 : 0)); }

namespace pg8 {
constexpr int BM = 256, BK = 64, HALF = 128, HTB = HALF * BK * 2, STAGE_BYTES = 8 * HTB, NXCD = 8, WGM = 8;
__host__ __device__ __forceinline__ int lds_byte(int r, int c) { const int st = (r >> 4) * 2 + (c >> 5), rr = r & 15, cc = c & 31, ob = rr * 64 + cc * 2; return st * 1024 + (ob ^ (((ob >> 9) & 1) << 5)); }
__host__ __device__ __forceinline__ void stage_rc(int b, int& R, int& C) { const int st = b / 1024, sb = b % 1024, swz = sb ^ (((sb >> 9) & 1) << 5); R = (st >> 1) * 16 + swz / 64; C = (st & 1) * 32 + (swz % 64) / 2; }
__host__ __device__ __forceinline__ int perm32(int rho) { const int n = rho >> 4, i = rho & 15; return 8 * (i >> 2) + 4 * n + (i & 3); }

struct Unit { int pm, pn; };
struct Gemm { const bf16_t* A; const bf16_t* Bt; int lda; int K; };

struct StaticOrder {
    int nM, nN, nwg, G, c, latent;
    __device__ void init(int M, int N, int G_, int c_, int latent_) { nM = M / BM; nN = N / BM; nwg = nM * nN; G = G_; c = c_; latent = latent_; }
    __device__ bool next(int i, Unit& u) const {
        const long L = (long)i * G + c; if (L >= nwg) return false;
        int wgid = (int)L; { const int q = nwg / NXCD, r = nwg % NXCD, xcd = wgid % NXCD, off = wgid / NXCD; wgid = (xcd < r ? xcd * (q + 1) : r * (q + 1) + (xcd - r) * q) + off; }
        const int nig = WGM * nN, gid = wgid / nig, fm = gid * WGM, gsz = (nM - fm) < WGM ? (nM - fm) : WGM;
        u.pm = fm + ((wgid % nig) % gsz); u.pn = (wgid % nig) / gsz;
        if (latent) u.pm += 1 + (u.pm >= 32 ? 1 : 0);
        return true;
    }
};

template <class Epi>
__device__ __forceinline__ void gemm_phase(LAS unsigned char* lds, const Gemm g, const StaticOrder& S, const Epi& E) {
    int tid_ = threadIdx.x; asm volatile("" : "+v"(tid_));
    const int tid = tid_, wid = __builtin_amdgcn_readfirstlane(tid >> 6), lane = tid & 63, wr = wid >> 2, wc = wid & 3, fr = lane & 15, fq = lane >> 4;
    const int K = g.K, nt = K / BK, lda = g.lda;
    unsigned voffA[2], voffB[2];
#pragma unroll
    for (int i = 0; i < 2; ++i) { int R, C; stage_rc(tid * 16 + i * 8192, R, C); const int Rb = Epi::PERM ? ((R & ~31) + perm32(R & 31)) : R;
        voffA[i] = (unsigned)(R * lda + C) * 2u; voffB[i] = (unsigned)(Rb * K + C) * 2u; }
    const size_t kstep = (size_t)(BK * 2);
    const size_t hstepA = (size_t)HALF * lda * 2, hstepB = (size_t)HALF * K * 2;
    const size_t tstepA = 2 * hstepA, tstepB = 2 * hstepB;
    const unsigned ldsw = (unsigned)wid * 1024u;
    const int aoff = lds_byte(wr * 64 + fr, fq * 8), boff = lds_byte(wc * 32 + fr, fq * 8);
#define PG8_SA(b, h) (((b) * 2 + (h)) * HTB)
#define PG8_SB(b, h) ((4 + (b) * 2 + (h)) * HTB)
#define PG8_STAGE(bufoff, gbase, voff) do { _Pragma("unroll") for (int _i = 0; _i < 2; ++_i) \
        __builtin_amdgcn_global_load_lds((const unsigned*)((const char*)(gbase) + (voff)[_i]), (LAS unsigned*)(lds + (bufoff) + ldsw + _i * 8192), 16, 0, 0); } while (0)
#define PG8_LDA(dst, b, h) do { _Pragma("unroll") for (int m = 0; m < 4; ++m) _Pragma("unroll") for (int k = 0; k < 2; ++k) dst[m][k] = *(const LAS bf16x8*)(lds + PG8_SA(b, h) + aoff + m * 2048 + k * 1024); } while (0)
#define PG8_LDB(dst, b, h) do { _Pragma("unroll") for (int n = 0; n < 2; ++n) _Pragma("unroll") for (int k = 0; k < 2; ++k) dst[n][k] = *(const LAS bf16x8*)(lds + PG8_SB(b, h) + boff + n * 2048 + k * 1024); } while (0)
#define PG8_MMA(ai, bj, At, Bt) do { __builtin_amdgcn_s_setprio(1); _Pragma("unroll") for (int m = 0; m < 4; ++m) _Pragma("unroll") for (int n = 0; n < 2; ++n) _Pragma("unroll") for (int k = 0; k < 2; ++k) \
        acc[ai][bj][m][n] = __builtin_amdgcn_mfma_f32_16x16x32_bf16(Bt[n][k], At[m][k], acc[ai][bj][m][n], 0, 0, 0); __builtin_amdgcn_s_setprio(0); } while (0)
#define PG8_WAIT_V(n) asm volatile("s_waitcnt vmcnt(" #n ")" ::: "memory")
#define PG8_WAIT_L(n) asm volatile("s_waitcnt lgkmcnt(" #n ")" ::: "memory")
#define PG8_BAR __builtin_amdgcn_s_barrier()
#define PG8_SCHED __builtin_amdgcn_sched_barrier(0)
    Unit cur, nxt; int ui = 0;
    if (!S.next(0, cur)) return;
    f32x4 acc[2][2][4][2];
#pragma unroll
    for (int a = 0; a < 2; ++a)
#pragma unroll
        for (int b = 0; b < 2; ++b)
#pragma unroll
            for (int m = 0; m < 4; ++m)
#pragma unroll
                for (int n = 0; n < 2; ++n) acc[a][b][m][n] = (f32x4){0.f, 0.f, 0.f, 0.f};
    bf16x8 At[4][2], B0[2][2], B1[2][2];
    const char* cA = (const char*)g.A + (size_t)cur.pm * tstepA; const char* cB = (const char*)g.Bt + (size_t)cur.pn * tstepB;
    PG8_STAGE(PG8_SB(0, 0), cB, voffB); PG8_STAGE(PG8_SB(0, 1), cB + hstepB, voffB); PG8_STAGE(PG8_SA(0, 0), cA, voffA); PG8_STAGE(PG8_SA(0, 1), cA + hstepA, voffA);
    if (wr == 1) PG8_BAR;
    PG8_WAIT_V(2); PG8_BAR;
    PG8_STAGE(PG8_SB(1, 0), cB + kstep, voffB); PG8_STAGE(PG8_SA(1, 0), cA + kstep, voffA); PG8_STAGE(PG8_SB(1, 1), cB + hstepB + kstep, voffB);
    PG8_WAIT_V(6); PG8_BAR;
    for (;;) {
        const bool has_next = S.next(ui + 1, nxt);
        const char* nA = has_next ? (const char*)g.A + (size_t)nxt.pm * tstepA : cA; const char* nB = has_next ? (const char*)g.Bt + (size_t)nxt.pn * tstepB : cB;
        for (int t = 0; t < nt; t += 2) {
            const bool last = (t == nt - 2);
            const char* a1 = cA + (size_t)(t + 1) * kstep;
            const char* a2 = last ? nA : cA + (size_t)(t + 2) * kstep; const char* b2 = last ? nB : cB + (size_t)(t + 2) * kstep;
            const char* a3 = a2 + kstep; const char* b3 = b2 + kstep;
            PG8_LDB(B0, 0, 0); PG8_LDB(B1, 0, 1); PG8_SCHED; PG8_LDA(At, 0, 0); PG8_STAGE(PG8_SA(1, 1), a1 + hstepA, voffA);
            PG8_WAIT_V(8); PG8_WAIT_L(0); PG8_BAR; PG8_MMA(0, 0, At, B0); PG8_MMA(0, 1, At, B1); PG8_BAR; PG8_SCHED;
            PG8_LDA(At, 0, 1); PG8_STAGE(PG8_SB(0, 0), b2, voffB); PG8_STAGE(PG8_SB(0, 1), b2 + hstepB, voffB); PG8_STAGE(PG8_SA(0, 0), a2, voffA);
            PG8_WAIT_V(8); PG8_WAIT_L(0); PG8_BAR; PG8_MMA(1, 0, At, B0); PG8_MMA(1, 1, At, B1); PG8_BAR; PG8_SCHED;
            PG8_LDB(B0, 1, 0); PG8_LDB(B1, 1, 1); PG8_SCHED; PG8_LDA(At, 1, 0); PG8_STAGE(PG8_SA(0, 1), a2 + hstepA, voffA);
            PG8_WAIT_V(8); PG8_WAIT_L(0); PG8_BAR; PG8_MMA(0, 0, At, B0); PG8_MMA(0, 1, At, B1); PG8_BAR; PG8_SCHED;
            PG8_LDA(At, 1, 1); PG8_STAGE(PG8_SB(1, 0), b3, voffB); PG8_STAGE(PG8_SB(1, 1), b3 + hstepB, voffB); PG8_STAGE(PG8_SA(1, 0), a3, voffA);
            PG8_WAIT_V(8); PG8_WAIT_L(0); PG8_BAR; PG8_MMA(1, 0, At, B0); PG8_MMA(1, 1, At, B1); PG8_BAR; PG8_SCHED;
        }
        if (wr == 0) PG8_BAR;
        E(acc, cur, wr, wc, fr, fq);
        if (!has_next) break;
#pragma unroll
        for (int a = 0; a < 2; ++a)
#pragma unroll
            for (int b = 0; b < 2; ++b)
#pragma unroll
                for (int m = 0; m < 4; ++m)
#pragma unroll
                    for (int n = 0; n < 2; ++n) acc[a][b][m][n] = (f32x4){0.f, 0.f, 0.f, 0.f};
        cur = nxt; cA = nA; cB = nB; ++ui;
        if (wr == 1) PG8_BAR;
    }
    PG8_WAIT_V(0);
    PG8_BAR;
#undef PG8_SA
#undef PG8_SB
#undef PG8_STAGE
#undef PG8_LDA
#undef PG8_LDB
#undef PG8_MMA
#undef PG8_WAIT_V
#undef PG8_WAIT_L
#undef PG8_BAR
#undef PG8_SCHED
}

typedef f32x4 Acc[2][2][4][2];

__device__ __forceinline__ void store8(bf16_t* p, f32x4 v0, f32x4 v1) {
    u32x4 w; w.x = cvt_pk_bf16(v0[0], v0[1]); w.y = cvt_pk_bf16(v0[2], v0[3]); w.z = cvt_pk_bf16(v1[0], v1[1]); w.w = cvt_pk_bf16(v1[2], v1[3]);
    *(u32x4*)p = w;
}
__device__ __forceinline__ void rope8(f32x4& v0, f32x4& v1, const LAS f32x2* tab  , int fq) {
    const f32x4 t0 = *(const LAS f32x4*)(tab), t1 = *(const LAS f32x4*)(tab + 2), t2 = *(const LAS f32x4*)(tab + 4), t3 = *(const LAS f32x4*)(tab + 6);
    const float cs[8] = {t0[0], t0[2], t1[0], t1[2], t2[0], t2[2], t3[0], t3[2]};
    const float sn[8] = {t0[1], t0[3], t1[1], t1[3], t2[1], t2[3], t3[1], t3[3]};
    const float sg = (fq < 2) ? -1.f : 1.f;
#pragma unroll
    for (int j = 0; j < 4; ++j) { const float p = __shfl_xor(v0[j], 32); v0[j] = v0[j] * cs[j] + sg * p * sn[j]; }
#pragma unroll
    for (int j = 0; j < 4; ++j) { const float p = __shfl_xor(v1[j], 32); v1[j] = v1[j] * cs[4 + j] + sg * p * sn[4 + j]; }
}

struct EpiIn {
    static constexpr bool PERM = true;
    bf16_t* Z; const LAS f32x2* rope; float* ssq_q; float* ssq_kv;
    __device__ __forceinline__ void operator()(const Acc& acc, const Unit& u, int wr, int wc, int fr, int fq) const {
        const int pn = u.pn, pmb = u.pm % 33;
        const bool ropetile = (pn < 8) || (pn == 15);
        const bool dorope = ropetile && (pmb != 0);
        const bool statt = (pn >= 12 && pn <= 14);
        const float sc = (pn < 4) ? C_DA : 1.f;
        const int t0 = (pmb - 1) * 256;
        const int row0 = u.pm * BM + wr * 64 + fr, col0 = pn * BM + wc * 32 + 8 * fq;
#pragma unroll
        for (int ai = 0; ai < 2; ++ai)
#pragma unroll
            for (int m = 0; m < 4; ++m) {
                const int pos = (wc & 1) ? (16 * m + fr) : ((t0 >> 6) + 2 * ai + wr);
                const LAS f32x2* tab = rope + pos * 16 + 8 * (fq & 1);
                bf16_t* rowp = Z + (size_t)(row0 + ai * HALF + m * 16) * ZW + col0;
                float sq = 0.f;
#pragma unroll
                for (int bj = 0; bj < 2; ++bj) {
                    f32x4 v0 = acc[ai][bj][m][0], v1 = acc[ai][bj][m][1];
                    if (dorope) rope8(v0, v1, tab, fq);
                    v0 = v0 * sc; v1 = v1 * sc;
                    if (statt) { const f32x4 q0 = v0 * v0, q1 = v1 * v1; sq += (q0[0] + q0[1]) + (q0[2] + q0[3]) + (q1[0] + q1[1]) + (q1[2] + q1[3]); }
                    store8(rowp + bj * HALF, v0, v1);
                }
                if (statt) { sq += __shfl_xor(sq, 16); sq += __shfl_xor(sq, 32);
                    if (fq == 0) atomicAdd((pn == 14 ? ssq_kv : ssq_q) + row0 + ai * HALF + m * 16, sq); }
            }
    }
};
struct EpiMq {
    static constexpr bool PERM = true;
    bf16_t* MQ; const LAS f32x2* rope; const float* rstd;
    __device__ __forceinline__ void operator()(const Acc& acc, const Unit& u, int wr, int wc, int fr, int fq) const {
        const int pn = u.pn, pmb = u.pm % 33;
        const int t0 = (pmb - 1) * 256;
        const int row0 = u.pm * BM + wr * 64 + fr, col0 = pn * BM + wc * 32 + 8 * fq;
#pragma unroll
        for (int ai = 0; ai < 2; ++ai) {
#pragma unroll
            for (int m = 0; m < 4; ++m) {
                const int row = row0 + ai * HALF + m * 16;
                const float rs = C_MLA / sqrtf(rstd[row] * (1.f / 512.f) + EPS);
                bf16_t* rowp = MQ + (size_t)row * MQW + col0;
#pragma unroll
                for (int bj = 0; bj < 2; ++bj) {
                    const int gm = (8 * pn + 4 * bj + wc) % 6;
                    f32x4 v0 = acc[ai][bj][m][0], v1 = acc[ai][bj][m][1];
                    if (gm >= 4) {
                        const int pos = (gm == 5) ? (16 * m + fr) : ((t0 >> 6) + 2 * ai + wr);
                        rope8(v0, v1, rope + pos * 16 + 8 * (fq & 1), fq);
                    }
                    v0 = v0 * rs; v1 = v1 * rs;
                    store8(rowp + bj * HALF, v0, v1);
                }
            }
            asm volatile("" ::: "memory");
        }
    }
};
struct EpiKv {
    static constexpr bool PERM = true;
    bf16_t* KV; const float* rstd;
    __device__ __forceinline__ void operator()(const Acc& acc, const Unit& u, int wr, int wc, int fr, int fq) const {
        const int row0 = u.pm * BM + wr * 64 + fr, col0 = u.pn * BM + wc * 32 + 8 * fq;
#pragma unroll
        for (int ai = 0; ai < 2; ++ai)
#pragma unroll
            for (int m = 0; m < 4; ++m) {
                const int row = row0 + ai * HALF + m * 16;
                const float rs = 1.0f / sqrtf(rstd[row] * (1.f / 256.f) + EPS);
                bf16_t* rowp = KV + (size_t)row * KVW + col0;
#pragma unroll
                for (int bj = 0; bj < 2; ++bj) store8(rowp + bj * HALF, acc[ai][bj][m][0] * rs, acc[ai][bj][m][1] * rs);
            }
    }
};
template <bool ADD> struct EpiMerge {
    static constexpr bool PERM = true;
    bf16_t* Y; const bf16_t* G;
    __device__ __forceinline__ void operator()(const Acc& acc, const Unit& u, int wr, int wc, int fr, int fq) const {
        const int row0 = u.pm * BM + wr * 64 + fr, col0 = u.pn * BM + wc * 32 + 8 * fq;
#pragma unroll
        for (int ai = 0; ai < 2; ++ai)
#pragma unroll
        for (int mh = 0; mh < 2; ++mh) {
            u32x4 gw[2][2], yw[2][2];
#pragma unroll
            for (int mm = 0; mm < 2; ++mm) { const int row = row0 + ai * HALF + (2 * mh + mm) * 16;
#pragma unroll
                for (int bj = 0; bj < 2; ++bj) { gw[mm][bj] = *(const u32x4*)(G + (size_t)row * ZW + col0 + bj * HALF);
                    if (ADD) yw[mm][bj] = *(const u32x4*)(Y + (size_t)row * DM + col0 + bj * HALF); } }
            asm volatile("" ::: "memory");
#pragma unroll
            for (int mm = 0; mm < 2; ++mm) { const int m = 2 * mh + mm; const int row = row0 + ai * HALF + m * 16;
                bf16_t* yp = Y + (size_t)row * DM + col0;
#pragma unroll
                for (int bj = 0; bj < 2; ++bj) {
                    const u32x4 g4 = gw[mm][bj];
                    f32x4 s0 = {sigmoidf_(bf_lo(g4.x)), sigmoidf_(bf_hi(g4.x)), sigmoidf_(bf_lo(g4.y)), sigmoidf_(bf_hi(g4.y))};
                    f32x4 s1 = {sigmoidf_(bf_lo(g4.z)), sigmoidf_(bf_hi(g4.z)), sigmoidf_(bf_lo(g4.w)), sigmoidf_(bf_hi(g4.w))};
                    f32x4 v0 = acc[ai][bj][m][0] * s0, v1 = acc[ai][bj][m][1] * s1;
                    if (ADD) { const u32x4 y4 = yw[mm][bj];
                        v0 += (f32x4){bf_lo(y4.x), bf_hi(y4.x), bf_lo(y4.y), bf_hi(y4.y)}; v1 += (f32x4){bf_lo(y4.z), bf_hi(y4.z), bf_lo(y4.w), bf_hi(y4.w)}; }
                    store8(yp + bj * HALF, v0, v1);
                } }
            asm volatile("" ::: "memory");
        }
    }
};
struct EpiRes {
    static constexpr bool PERM = false;
    const float* base; float* out; const float* mod; const float* bada; int goff;
    __device__ __forceinline__ void operator()(const Acc& acc, const Unit& u, int wr, int wc, int fr, int fq) const {
        const int row0 = u.pm * BM + wr * 64 + fr, col0 = u.pn * BM + wc * 32 + 4 * fq;
        const int b = (u.pm >= 33) ? 1 : 0;
        f32x4 gv[2][2];
#pragma unroll
        for (int bj = 0; bj < 2; ++bj)
#pragma unroll
            for (int n = 0; n < 2; ++n) gv[bj][n] = *(const f32x4*)(mod + b * MODW + goff + col0 + bj * HALF + 16 * n) + *(const f32x4*)(bada + goff + col0 + bj * HALF + 16 * n);
#pragma unroll
        for (int ai = 0; ai < 2; ++ai)
#pragma unroll
        for (int mh = 0; mh < 2; ++mh) {
            f32x4 bs[2][2][2];
#pragma unroll
            for (int mm = 0; mm < 2; ++mm) { const int m = 2 * mh + mm; const size_t off = (size_t)r_to_l(row0 + ai * HALF + m * 16) * DM + col0;
#pragma unroll
                for (int bj = 0; bj < 2; ++bj)
#pragma unroll
                    for (int n = 0; n < 2; ++n) bs[mm][bj][n] = *(const f32x4*)(base + off + bj * HALF + 16 * n); }
            asm volatile("" ::: "memory");
#pragma unroll
            for (int mm = 0; mm < 2; ++mm) { const int m = 2 * mh + mm; const size_t off = (size_t)r_to_l(row0 + ai * HALF + m * 16) * DM + col0;
#pragma unroll
                for (int bj = 0; bj < 2; ++bj)
#pragma unroll
                    for (int n = 0; n < 2; ++n) *(f32x4*)(out + off + bj * HALF + 16 * n) = bs[mm][bj][n] + gv[bj][n] * acc[ai][bj][m][n]; }
            asm volatile("" ::: "memory");
        }
    }
};
struct EpiSwiglu {
    static constexpr bool PERM = true;
    bf16_t* ACT;
    __device__ __forceinline__ void operator()(const Acc& acc, const Unit& u, int wr, int wc, int fr, int fq) const {
        const int row0 = u.pm * BM + wr * 64 + fr, col0 = u.pn * HALF + wc * 32 + 8 * fq;
#pragma unroll
        for (int ai = 0; ai < 2; ++ai)
#pragma unroll
            for (int m = 0; m < 4; ++m) {
                const int row = row0 + ai * HALF + m * 16;
                f32x4 o[2];
#pragma unroll
                for (int n = 0; n < 2; ++n) {
                    const f32x4 gt = acc[ai][0][m][n], up = acc[ai][1][m][n];
#pragma unroll
                    for (int j = 0; j < 4; ++j) o[n][j] = gt[j] * sigmoidf_(gt[j]) * up[j];
                }
                store8(ACT + (size_t)row * FF + col0, o[0], o[1]);
            }
    }
};
}

namespace att {
constexpr int NT = ROWS_B / 64;
constexpr int L_KN = 0, KN_B = 16384;
constexpr int L_KR = 32768, KR_B = 8192;
constexpr int L_V = 49152, V_B = 16384;
constexpr int L_WS = 98304;
constexpr int L_Q = 100352;
constexpr float THR = 8.f;
#define SBAR() __builtin_amdgcn_sched_barrier(0)
__device__ __forceinline__ int crow(int r, int hi) { return (r & 3) + 8 * (r >> 2) + 4 * hi; }

__device__ __forceinline__ void partialSM(f32x16& p0, f32x16& p1, float& m_reg, float& alpha) {
    float pmax = p0[0];
#pragma unroll
    for (int r = 1; r < 16; ++r) pmax = fmaxf(pmax, p0[r]);
#pragma unroll
    for (int r = 0; r < 16; ++r) pmax = fmaxf(pmax, p1[r]);
    { auto rr = __builtin_amdgcn_permlane32_swap(__float_as_uint(pmax), __float_as_uint(pmax), false, false);
      pmax = fmaxf(__uint_as_float(rr[0]), __uint_as_float(rr[1])); }
    float mn;
    if (__builtin_expect(__all(pmax - m_reg <= THR), 1)) { mn = m_reg; alpha = 1.f; }
    else { mn = fmaxf(m_reg, pmax); alpha = __builtin_amdgcn_exp2f(m_reg - mn); m_reg = mn; }
#pragma unroll
    for (int r = 0; r < 16; ++r) p0[r] = p0[r] - mn;
#pragma unroll
    for (int r = 0; r < 16; ++r) p1[r] = p1[r] - mn;
#pragma unroll
    for (int r = 0; r < 16; ++r) p0[r] = __builtin_amdgcn_exp2f(p0[r]);
}
__device__ __forceinline__ void partialSM_rel(f32x16& p0, f32x16& p1, float& m_reg, float& alpha, f32x16& negm) {
    float pmax = p0[0];
#pragma unroll
    for (int r = 1; r < 16; ++r) pmax = fmaxf(pmax, p0[r]);
#pragma unroll
    for (int r = 0; r < 16; ++r) pmax = fmaxf(pmax, p1[r]);
    { auto rr = __builtin_amdgcn_permlane32_swap(__float_as_uint(pmax), __float_as_uint(pmax), false, false);
      pmax = fmaxf(__uint_as_float(rr[0]), __uint_as_float(rr[1])); }
    if (__builtin_expect(__all(pmax <= THR), 1)) { alpha = 1.f; }
    else { const float dl = fmaxf(pmax, 0.f); m_reg += dl; alpha = __builtin_amdgcn_exp2f(-dl);
#pragma unroll
        for (int r = 0; r < 16; ++r) { p0[r] -= dl; p1[r] -= dl; }
        const float nm = -m_reg;
#pragma unroll
        for (int r = 0; r < 16; ++r) negm[r] = nm;
        asm volatile("" : "+v"(negm)); }
#pragma unroll
    for (int r = 0; r < 16; ++r) p0[r] = __builtin_amdgcn_exp2f(p0[r]);
}
__device__ __forceinline__ void finishSM(f32x16& p0, f32x16& p1, float alpha, float& l_reg, bf16x8& pa0, bf16x8& pa1, bf16x8& pa2, bf16x8& pa3) {
#pragma unroll
    for (int r = 0; r < 16; ++r) p1[r] = __builtin_amdgcn_exp2f(p1[r]);
    float ps = 0;
#pragma unroll
    for (int r = 0; r < 16; ++r) ps += p0[r];
#pragma unroll
    for (int r = 0; r < 16; ++r) ps += p1[r];
    { auto rr = __builtin_amdgcn_permlane32_swap(__float_as_uint(ps), __float_as_uint(ps), false, false);
      ps = __uint_as_float(rr[0]) + __uint_as_float(rr[1]); }
    l_reg = l_reg * alpha + ps;
#define PK4(P, BASE, OUT) do { unsigned a0 = cvt_pk_bf16(P[BASE + 0], P[BASE + 1]), a1 = cvt_pk_bf16(P[BASE + 2], P[BASE + 3]);   \
    unsigned b0 = cvt_pk_bf16(P[BASE + 4], P[BASE + 5]), b1 = cvt_pk_bf16(P[BASE + 6], P[BASE + 7]);                              \
    u32x4 w = {a0, a1, b0, b1}; OUT = __builtin_bit_cast(bf16x8, w); } while (0)
    PK4(p0, 0, pa0); PK4(p0, 8, pa1); PK4(p1, 0, pa2); PK4(p1, 8, pa3);
#undef PK4
}
template <bool NOPE>
__device__ __forceinline__ void qkt(f32x16& p0, f32x16& p1, const LAS char* Kn, const LAS char* Kr, const bf16x8* qr, const LAS char* qlds, int r32, int hi) {
    p0 = f32x16{}; p1 = f32x16{};
    if (NOPE) {
        const int x = r32 & 15;
#pragma unroll
        for (int d0 = 0; d0 < 8; ++d0) { const int ch = ((2 * d0 + hi) ^ x) << 4;
            const bf16x8 b0 = *(const LAS bf16x8*)(Kn + r32 * 256 + ch);
            const bf16x8 b1 = *(const LAS bf16x8*)(Kn + (32 + r32) * 256 + ch);
            bf16x8 q; if (d0 < 5) q = qr[d0]; else q = *(const LAS bf16x8*)(qlds + (d0 - 5) * 1024);
            p0 = __builtin_amdgcn_mfma_f32_32x32x16_bf16(b0, q, p0, 0, 0, 0);
            p1 = __builtin_amdgcn_mfma_f32_32x32x16_bf16(b1, q, p1, 0, 0, 0); }
    }
    const int f = (r32 >> 1) & 7;
#pragma unroll
    for (int d0 = 0; d0 < 4; ++d0) { const int ch = ((2 * d0 + hi) ^ f) << 4;
        const bf16x8 b0 = *(const LAS bf16x8*)(Kr + r32 * 128 + ch);
        const bf16x8 b1 = *(const LAS bf16x8*)(Kr + (32 + r32) * 128 + ch);
        bf16x8 q; if (NOPE) q = *(const LAS bf16x8*)(qlds + (3 + d0) * 1024); else q = qr[d0];
        p0 = __builtin_amdgcn_mfma_f32_32x32x16_bf16(b0, q, p0, 0, 0, 0);
        p1 = __builtin_amdgcn_mfma_f32_32x32x16_bf16(b1, q, p1, 0, 0, 0); }
}
template <bool NOPE>
__device__ __forceinline__ void qkt_pipe(f32x16& p0, f32x16& p1, const LAS char* Kn, const LAS char* Kr, const bf16x8* qr, const LAS char* qlds, int r32, int hi, const f32x16& negm) {
    constexpr int NC = NOPE ? 6 : 2;
    const int x = r32 & 15, f = (r32 >> 1) & 7;
    const LAS char* kn0 = Kn + r32 * 256; const LAS char* kr0 = Kr + r32 * 128;
    bf16x8 ka[4], kb[4], qa[2], qb[2];
#define LOADC(k, q, c) do { _Pragma("unroll") for (int i_ = 0; i_ < 2; ++i_) { const int d0 = 2 * (c) + i_; \
        if (NOPE && d0 < 8) { const int ch = ((2 * d0 + hi) ^ x) << 4; k[2 * i_] = *(const LAS bf16x8*)(kn0 + ch); k[2 * i_ + 1] = *(const LAS bf16x8*)(kn0 + 32 * 256 + ch); } \
        else { const int dr = d0 - (NOPE ? 8 : 0); const int ch = ((2 * dr + hi) ^ f) << 4; k[2 * i_] = *(const LAS bf16x8*)(kr0 + ch); k[2 * i_ + 1] = *(const LAS bf16x8*)(kr0 + 32 * 128 + ch); } \
        if (NOPE) { if (d0 < 5) q[i_] = qr[d0]; else q[i_] = *(const LAS bf16x8*)(qlds + (d0 - 5) * 1024); } else q[i_] = qr[d0]; } } while (0)
#define MMAC(k, q) do { _Pragma("unroll") for (int i_ = 0; i_ < 2; ++i_) { \
        p0 = __builtin_amdgcn_mfma_f32_32x32x16_bf16(k[2 * i_], q[i_], p0, 0, 0, 0); p1 = __builtin_amdgcn_mfma_f32_32x32x16_bf16(k[2 * i_ + 1], q[i_], p1, 0, 0, 0); } } while (0)
    LOADC(ka, qa, 0); LOADC(kb, qb, 1); SBAR();
    if (NOPE) { p0 = f32x16{}; p1 = f32x16{}; p0 = __builtin_amdgcn_mfma_f32_32x32x16_bf16(ka[0], qa[0], p0, 0, 0, 0); p1 = __builtin_amdgcn_mfma_f32_32x32x16_bf16(ka[1], qa[0], p1, 0, 0, 0); }
    else { p0 = __builtin_amdgcn_mfma_f32_32x32x16_bf16(ka[0], qa[0], negm, 0, 0, 0); p1 = __builtin_amdgcn_mfma_f32_32x32x16_bf16(ka[1], qa[0], negm, 0, 0, 0); }
    p0 = __builtin_amdgcn_mfma_f32_32x32x16_bf16(ka[2], qa[1], p0, 0, 0, 0); p1 = __builtin_amdgcn_mfma_f32_32x32x16_bf16(ka[3], qa[1], p1, 0, 0, 0); SBAR();
    if (NC > 2) {
        LOADC(ka, qa, 2); SBAR(); MMAC(kb, qb); SBAR();
        LOADC(kb, qb, 3); SBAR(); MMAC(ka, qa); SBAR();
        LOADC(ka, qa, 4); SBAR(); MMAC(kb, qb); SBAR();
        LOADC(kb, qb, 5); SBAR(); MMAC(ka, qa); SBAR();
        MMAC(kb, qb); SBAR();
    } else {
        MMAC(kb, qb); SBAR();
    }
#undef LOADC
#undef MMAC
}
__device__ __forceinline__ int v_st(int k, int c) { const int kk = (k & ~0xC) | ((k & 4) << 1) | ((k & 8) >> 1); return ((kk >> 3) * 4 + (c >> 5)) * 512 + ((kk & 7) * 32 + (c & 31)) * 2; }
__device__ __forceinline__ int v_rd_base(int lane) { return ((lane & 3) << 3) | (((lane >> 2) & 3) << 6) | (((lane >> 4) & 1) << 5) | (((lane >> 5) & 1) << 8); }
constexpr int v_rd_off(int d0, int ks, int half) { return d0 * 512 + ks * 4096 + half * 2048; }
template <int OFF> __device__ __forceinline__ s16x4 tr_read(int vb) {
    s16x4 r; asm volatile("ds_read_b64_tr_b16 %0, %1 offset:%2" : "=&v"(r) : "v"(vb), "i"(OFF) : "memory"); return r;
}
template <int D0> __device__ __forceinline__ void pv_one(f32x16& od, int vb, bf16x8 pa0, bf16x8 pa1, bf16x8 pa2, bf16x8 pa3) {
    const s16x4 l0 = tr_read<v_rd_off(D0, 0, 0)>(vb), h0 = tr_read<v_rd_off(D0, 0, 1)>(vb), l1 = tr_read<v_rd_off(D0, 1, 0)>(vb), h1 = tr_read<v_rd_off(D0, 1, 1)>(vb);
    const s16x4 l2 = tr_read<v_rd_off(D0, 2, 0)>(vb), h2 = tr_read<v_rd_off(D0, 2, 1)>(vb), l3 = tr_read<v_rd_off(D0, 3, 0)>(vb), h3 = tr_read<v_rd_off(D0, 3, 1)>(vb);
    asm volatile("s_waitcnt lgkmcnt(0)" ::: "memory"); SBAR();
#define PK(L, H) (bf16x8){L[0], L[1], L[2], L[3], H[0], H[1], H[2], H[3]}
    od = __builtin_amdgcn_mfma_f32_32x32x16_bf16(pa0, PK(l0, h0), od, 0, 0, 0);
    od = __builtin_amdgcn_mfma_f32_32x32x16_bf16(pa1, PK(l1, h1), od, 0, 0, 0);
    od = __builtin_amdgcn_mfma_f32_32x32x16_bf16(pa2, PK(l2, h2), od, 0, 0, 0);
    od = __builtin_amdgcn_mfma_f32_32x32x16_bf16(pa3, PK(l3, h3), od, 0, 0, 0);
#undef PK
}
__device__ __forceinline__ void pv_d0(f32x16* o, int vb, bf16x8 pa0, bf16x8 pa1, bf16x8 pa2, bf16x8 pa3) {
    pv_one<0>(o[0], vb, pa0, pa1, pa2, pa3); pv_one<1>(o[1], vb, pa0, pa1, pa2, pa3); pv_one<2>(o[2], vb, pa0, pa1, pa2, pa3); pv_one<3>(o[3], vb, pa0, pa1, pa2, pa3);
}

template <bool NOPE, int ldkn, int ldkr, int ldv, bool TWO>
__device__ __forceinline__ void attn_pass(LAS char* lds, const bf16_t* Qw, const bf16_t* Kn, const bf16_t* Kr, const bf16_t* V, f32x16 (&o)[4]) {
    int tid_ = threadIdx.x; asm volatile("" : "+v"(tid_));
    const int tid = tid_, lane = tid & 63, r32 = lane & 31, hi = lane >> 5; const int wid = __builtin_amdgcn_readfirstlane(tid >> 6);
    LAS float* ws = (LAS float*)(lds + L_WS) + wid * 64; LAS float* li_l = ws; LAS float* al_l = ws + 32;
    constexpr int NQ = NOPE ? 5 : 4;
    bf16x8 qr[NQ];
#pragma unroll
    for (int d0 = 0; d0 < NQ; ++d0) qr[d0] = *(const bf16x8*)(Qw + d0 * 16);
    const LAS char* qlds = lds + L_Q + wid * 7168 + lane * 16;
    if (NOPE) {
#pragma unroll
        for (int d0 = 0; d0 < 7; ++d0) *(LAS bf16x8*)(lds + L_Q + wid * 7168 + lane * 16 + d0 * 1024) = *(const bf16x8*)(Qw + (5 + d0) * 16);
    }
    unsigned okn0 = 0, okn1 = 0;
    if (NOPE) {
        { const int b = (wid * 2) * 1024 + lane * 16, row = b >> 8, ch = ((b & 255) >> 4) ^ (row & 15); okn0 = (unsigned)(row * ldkn + ch * 8) * 2u; }
        { const int b = (wid * 2 + 1) * 1024 + lane * 16, row = b >> 8, ch = ((b & 255) >> 4) ^ (row & 15); okn1 = (unsigned)(row * ldkn + ch * 8) * 2u; }
    }
    unsigned okr; { const int b = wid * 1024 + lane * 16, row = b >> 7, ch = ((b & 127) >> 4) ^ ((row >> 1) & 7); okr = (unsigned)(row * ldkr + ch * 8) * 2u; }
    unsigned ov0, ov1;
    { const int off = (wid * 2) * 1024 + lane * 16, sub = off >> 9, w = (off & 511) >> 1, kk = (sub >> 2) * 8 + (w >> 5), k = kk  , c = (sub & 3) * 32 + (w & 31);
      ov0 = (unsigned)(k * ldv + c) * 2u; }
    { const int off = (wid * 2 + 1) * 1024 + lane * 16, sub = off >> 9, w = (off & 511) >> 1, kk = (sub >> 2) * 8 + (w >> 5), k = kk  , c = (sub & 3) * 32 + (w & 31);
      ov1 = (unsigned)(k * ldv + c) * 2u; }
    const char* bkn = (const char*)Kn; const char* bkr = (const char*)Kr; const char* bv = (const char*)V;
    const size_t kn_step = (size_t)64 * ldkn * 2, kr_step = (size_t)64 * ldkr * 2, v_step = (size_t)64 * ldv * 2;
    const unsigned wo1 = (unsigned)wid * 1024u, wo2 = (unsigned)wid * 2048u;
#define GLDS(src, dstoff) __builtin_amdgcn_global_load_lds((const unsigned*)(src), (LAS unsigned*)(lds + (dstoff)), 16, 0, 0)
#define DMA_TILE(kb, vslot) do { \
    if (NOPE) { GLDS(bkn + okn0, L_KN + (kb) * KN_B + wo2); GLDS(bkn + okn1, L_KN + (kb) * KN_B + wo2 + 1024u); bkn += kn_step; } \
    GLDS(bkr + okr, L_KR + (kb) * KR_B + wo1); bkr += kr_step; \
    GLDS(bv + ov0, L_V + (vslot) + wo2); GLDS(bv + ov1, L_V + (vslot) + wo2 + 1024u); bv += v_step; } while (0)
    constexpr int PF_AHEAD = 3;
    const char* pfp = nullptr;
    if (!NOPE) { const int li = tid % 192; pfp = (li < 64) ? (const char*)(Kr + (size_t)li * ldkr) : (const char*)(V + (size_t)((li - 64) >> 1) * ldv + ((li - 64) & 1) * 64);
                 pfp += (size_t)PF_AHEAD * kr_step; }
    int pft = PF_AHEAD;
#define PREFETCH() do { if (!NOPE) { const char* p_ = (pft < NT) ? pfp : pfp - (size_t)PF_AHEAD * kr_step; __builtin_amdgcn_global_load_lds((const unsigned*)p_, (LAS unsigned*)(lds + L_Q + wid * 256), 4, 0, 0); pfp += kr_step; ++pft; } } while (0)
#define WAITSYNC() do { asm volatile("s_waitcnt vmcnt(0)" ::: "memory"); __syncthreads(); } while (0)
#define RESC(a) do { if (__any((a) < 1.f)) { if (hi == 0) al_l[r32] = (a); asm volatile("s_waitcnt lgkmcnt(0)" ::: "memory"); \
    _Pragma("unroll") for (int d = 0; d < 4; ++d) _Pragma("unroll") for (int r = 0; r < 16; ++r) o[d][r] *= al_l[crow(r, hi)]; } } while (0)
    const LAS char* Kn0 = lds + L_KN; const LAS char* Kn1 = lds + L_KN + KN_B; const LAS char* Kr0 = lds + L_KR; const LAS char* Kr1 = lds + L_KR + KR_B;
    const int vb0 = (int)(unsigned)(uintptr_t)(lds + L_V) + v_rd_base(lane);
    float m_reg = -1e30f, l_reg = 0.f;
#pragma unroll
    for (int d = 0; d < 4; ++d) o[d] = f32x16{};
    f32x16 pA0, pA1, pB0, pB1; float alA, alB; bf16x8 pa0, pa1, pa2, pa3;
    int sl_prev = 0, sl_cur = V_B, sl_next = 2 * V_B;
#define ROT() do { const int t_ = sl_prev; sl_prev = sl_cur; sl_cur = sl_next; sl_next = t_; } while (0)
    if (TWO) {
    DMA_TILE(0, 0);
    WAITSYNC();
    DMA_TILE(1, V_B);
    qkt<NOPE>(pA0, pA1, Kn0, Kr0, qr, qlds, r32, hi); partialSM(pA0, pA1, m_reg, alA);
    WAITSYNC();
    for (int j = 1; j + 1 < NT; j += 2) {
        DMA_TILE(0, sl_next);
        SBAR(); qkt<NOPE>(pB0, pB1, Kn1, Kr1, qr, qlds, r32, hi);
        finishSM(pA0, pA1, alA, l_reg, pa0, pa1, pa2, pa3); SBAR();
        pv_d0(o, vb0 + sl_prev, pa0, pa1, pa2, pa3); partialSM(pB0, pB1, m_reg, alB);
        RESC(alB);
        WAITSYNC(); ROT();
        DMA_TILE(1, sl_next);
        SBAR(); qkt<NOPE>(pA0, pA1, Kn0, Kr0, qr, qlds, r32, hi);
        finishSM(pB0, pB1, alB, l_reg, pa0, pa1, pa2, pa3); SBAR();
        pv_d0(o, vb0 + sl_prev, pa0, pa1, pa2, pa3); partialSM(pA0, pA1, m_reg, alA);
        RESC(alA);
        WAITSYNC(); ROT();
    }
    SBAR(); qkt<NOPE>(pB0, pB1, Kn1, Kr1, qr, qlds, r32, hi);
    finishSM(pA0, pA1, alA, l_reg, pa0, pa1, pa2, pa3); SBAR();
    pv_d0(o, vb0 + sl_prev, pa0, pa1, pa2, pa3); partialSM(pB0, pB1, m_reg, alB);
    RESC(alB);
    finishSM(pB0, pB1, alB, l_reg, pa0, pa1, pa2, pa3); SBAR();
    pv_d0(o, vb0 + sl_cur, pa0, pa1, pa2, pa3);
    } else {
        const int grp = wid >> 2;
#define BAR() __builtin_amdgcn_s_barrier()
#define VMW() do { if (NOPE) asm volatile("s_waitcnt vmcnt(0)" ::: "memory"); else asm volatile("s_waitcnt vmcnt(1)" ::: "memory"); } while (0)
#define SMB0() do { partialSM(pA0, pA1, m_reg, alA); RESC(alA); finishSM(pA0, pA1, alA, l_reg, pa0, pa1, pa2, pa3); } while (0)
#define SMB() do { if (NOPE) partialSM(pA0, pA1, m_reg, alA); else partialSM_rel(pA0, pA1, m_reg, alA, negm); RESC(alA); finishSM(pA0, pA1, alA, l_reg, pa0, pa1, pa2, pa3); } while (0)
        s16x4 va[8], vbq[8]; f32x16 negm = f32x16{};
#define VLD(dst, D0, vb) do { dst[0] = tr_read<v_rd_off(D0, 0, 0)>(vb); dst[1] = tr_read<v_rd_off(D0, 0, 1)>(vb); dst[2] = tr_read<v_rd_off(D0, 1, 0)>(vb); dst[3] = tr_read<v_rd_off(D0, 1, 1)>(vb); \
                               dst[4] = tr_read<v_rd_off(D0, 2, 0)>(vb); dst[5] = tr_read<v_rd_off(D0, 2, 1)>(vb); dst[6] = tr_read<v_rd_off(D0, 3, 0)>(vb); dst[7] = tr_read<v_rd_off(D0, 3, 1)>(vb); } while (0)
#define PKV(L, H) (bf16x8){L[0], L[1], L[2], L[3], H[0], H[1], H[2], H[3]}
#define VMM(od, src) do { od = __builtin_amdgcn_mfma_f32_32x32x16_bf16(pa0, PKV(src[0], src[1]), od, 0, 0, 0); od = __builtin_amdgcn_mfma_f32_32x32x16_bf16(pa1, PKV(src[2], src[3]), od, 0, 0, 0); \
                           od = __builtin_amdgcn_mfma_f32_32x32x16_bf16(pa2, PKV(src[4], src[5]), od, 0, 0, 0); od = __builtin_amdgcn_mfma_f32_32x32x16_bf16(pa3, PKV(src[6], src[7]), od, 0, 0, 0); } while (0)
#define LGK(n) asm volatile("s_waitcnt lgkmcnt(" #n ")" ::: "memory")
#define VPRE0(vslot) do { if (!NOPE) { SBAR(); VLD(va, 0, vb0 + (vslot)); SBAR(); } } while (0)
#define MBLOCK(KN, KR, vslot) do { const int vb_ = vb0 + (vslot); \
            qkt_pipe<NOPE>(pA0, pA1, KN, KR, qr, qlds, r32, hi, negm); SBAR(); if (NOPE) { VLD(va, 0, vb_); SBAR(); } \
            VLD(vbq, 1, vb_); LGK(8); SBAR(); VMM(o[0], va); SBAR(); \
            VLD(va, 2, vb_); LGK(8); SBAR(); VMM(o[1], vbq); SBAR(); \
            VLD(vbq, 3, vb_); LGK(8); SBAR(); VMM(o[2], va); SBAR(); \
            LGK(0); SBAR(); VMM(o[3], vbq); SBAR(); } while (0)
        DMA_TILE(0, 0);
        if (grp == 1) DMA_TILE(1, V_B);
        asm volatile("s_waitcnt vmcnt(0)" ::: "memory"); __syncthreads();
        if (grp == 1) { __builtin_amdgcn_s_setprio(1); BAR(); }
        SBAR(); qkt<NOPE>(pA0, pA1, Kn0, Kr0, qr, qlds, r32, hi); SBAR();
        if (grp == 0) { DMA_TILE(1, V_B); PREFETCH(); }
        if (grp == 1) VMW();
        BAR();
        if (grp == 1) { DMA_TILE(0, 2 * V_B); PREFETCH(); }
        SMB0();
        if (!NOPE) { const float nm = -m_reg;
#pragma unroll
          for (int r = 0; r < 16; ++r) negm[r] = nm;
          asm volatile("" : "+v"(negm)); }
        VPRE0(0);
        if (grp == 0) VMW();
        BAR();
        int s0 = 0, s1 = V_B, s2 = 2 * V_B;
#define ROT3() do { const int t_ = s0; s0 = s1; s1 = s2; s2 = t_; } while (0)
        for (int j = 1; j + 1 < NT; j += 2) {
            MBLOCK(Kn1, Kr1, s0);
            if (grp == 1) VMW();
            BAR();
            if (grp == 0) { DMA_TILE(0, s2); PREFETCH(); }
            if (grp == 1) { DMA_TILE(1, s0); PREFETCH(); }
            SMB();
            VPRE0(s1);
            if (grp == 0) VMW();
            BAR();
            ROT3();
            MBLOCK(Kn0, Kr0, s0);
            if (grp == 1) VMW();
            BAR();
            if (grp == 0) { DMA_TILE(1, s2); PREFETCH(); }
            if (grp == 1 && j + 3 < NT) { DMA_TILE(0, s0); PREFETCH(); }
            SMB();
            VPRE0(s1);
            if (grp == 0) VMW();
            BAR();
            ROT3();
        }
        MBLOCK(Kn1, Kr1, s0);
        if (grp == 1) VMW();
        BAR();
        SMB();
        VPRE0(s1);
        BAR();
        ROT3();
        { const int vb_ = vb0 + s0; if (NOPE) VLD(va, 0, vb_); VLD(vbq, 1, vb_); LGK(8); SBAR(); VMM(o[0], va); SBAR();
          VLD(va, 2, vb_); LGK(8); SBAR(); VMM(o[1], vbq); SBAR();
          VLD(vbq, 3, vb_); LGK(8); SBAR(); VMM(o[2], va); SBAR();
          LGK(0); SBAR(); VMM(o[3], vbq); SBAR(); }
        if (grp == 0) BAR();
        __builtin_amdgcn_s_setprio(0);
#undef BAR
#undef VMW
#undef SMB
#undef SMB0
#undef VLD
#undef PKV
#undef VMM
#undef LGK
#undef MBLOCK
#undef VPRE0
#undef ROT3
    }
    if (hi == 0) li_l[r32] = l_reg; asm volatile("s_waitcnt lgkmcnt(0)" ::: "memory");
#pragma unroll
    for (int r = 0; r < 16; ++r) { const float rl = __builtin_amdgcn_rcpf(li_l[crow(r, hi)]);
#pragma unroll
        for (int d = 0; d < 4; ++d) o[d][r] *= rl; }
    asm volatile("s_waitcnt vmcnt(0)" ::: "memory");
    __syncthreads();
#undef GLDS
#undef DMA_TILE
#undef WAITSYNC
#undef PREFETCH
#undef RESC
#undef ROT
}
#undef SBAR
}

#define XB_TMO      128
#define XB_XCNT(j)  (256  + 64 * (j))
#define XB_XSUB(j)  (1280 + 64 * (j))
#define XB_XGEN(j)  (2304 + 64 * (j))
#define XB_TOP      3328
#define XB_TOPGEN   3392
#define XCD_BAR_WORDS 3456
#define XB_SPIN_CAP (1u << 18)

__device__ __forceinline__ unsigned xb_ld(unsigned* p)              { return __hip_atomic_load(p, __ATOMIC_RELAXED, __HIP_MEMORY_SCOPE_AGENT); }
__device__ __forceinline__ unsigned xb_add(unsigned* p, unsigned v) { return __hip_atomic_fetch_add(p, v, __ATOMIC_RELAXED, __HIP_MEMORY_SCOPE_AGENT); }
__device__ __forceinline__ unsigned xb_xcc_id() { return (unsigned)__builtin_amdgcn_s_getreg((3 << 11) | 20) & 0xFu; }
#define XB_SPIN(cond, bar) do { unsigned _sp = 0; while (cond) { __builtin_amdgcn_s_sleep(1); \
    if ((++_sp & 255u) == 0u) { if (xb_ld(&(bar)[XB_TMO])) break; if (_sp > XB_SPIN_CAP) { atomicAdd(&(bar)[XB_TMO], 1u); break; } } } } while (0)

struct XcdBarrier {
    unsigned* bar; unsigned x;
    volatile LAS unsigned* st;
};

__device__ __forceinline__ XcdBarrier xcd_barrier_post(unsigned* bar, volatile LAS unsigned* st) {
    XcdBarrier b; b.bar = bar; b.x = xb_xcc_id(); b.st = st;
    if (threadIdx.x == 0) (void)xb_add(&bar[XB_XCNT(b.x)], 1u);
    return b;
}
__device__ __forceinline__ void xcd_barrier_complete(unsigned* bar, unsigned x, unsigned& nloc, unsigned& nx) {
    const unsigned G = gridDim.x * gridDim.y * gridDim.z;
    unsigned sum, cnt, mine, sp = 0u;
    for (;;) {
        sum = 0u; cnt = 0u; mine = 0u;
#pragma unroll
        for (unsigned j = 0; j < 16; ++j) { const unsigned c = xb_ld(&bar[XB_XCNT(j)]); sum += c; cnt += (c > 0u) ? 1u : 0u; mine = (j == x) ? c : mine; }
        if (sum == G) break;
        __builtin_amdgcn_s_sleep(1);
        if ((++sp & 255u) == 0u) { if (xb_ld(&bar[XB_TMO])) break; if (sp > XB_SPIN_CAP) { atomicAdd(&bar[XB_TMO], 1u); break; } }
    }
    nloc = mine > 0u ? mine : 1u; nx = cnt > 0u ? cnt : 1u;
}

__device__ __forceinline__ void xcd_barrier(const XcdBarrier& b) {
    asm volatile("s_waitcnt vmcnt(0)" ::: "memory");
    __syncthreads();
    if (threadIdx.x == 0) {
        unsigned* bar = b.bar;
        __builtin_amdgcn_s_waitcnt(0);
        unsigned nloc = b.st[0], nx = b.st[1];
        if (nloc == 0u) { xcd_barrier_complete(bar, b.x, nloc, nx); b.st[0] = nloc; b.st[1] = nx; }
        const unsigned old = xb_add(&bar[XB_XSUB(b.x)], 1u);
        const unsigned gen = old / nloc;
        if (old + 1u == (gen + 1u) * nloc) {
            __builtin_amdgcn_fence(__ATOMIC_RELEASE, "agent");
            asm volatile("s_waitcnt vmcnt(0)" ::: "memory");
            const unsigned og = xb_add(&bar[XB_TOP], 1u);
            const unsigned tg = og / nx;
            if (og + 1u == (tg + 1u) * nx) xb_add(&bar[XB_TOPGEN], 1u);
            else XB_SPIN(xb_ld(&bar[XB_TOPGEN]) == tg, bar);
            __builtin_amdgcn_fence(__ATOMIC_ACQUIRE, "agent");
            xb_add(&bar[XB_XGEN(b.x)], 1u);
            asm volatile("s_waitcnt vmcnt(0)" ::: "memory");
        } else {
            XB_SPIN(xb_ld(&bar[XB_XGEN(b.x)]) == gen, bar);
            __builtin_amdgcn_fence(__ATOMIC_ACQUIRE, "agent");
            asm volatile("s_waitcnt vmcnt(0)" ::: "memory");
        }
    }
    __syncthreads();
}


constexpr int N_PHASES_K = 12;
struct Args { const float* in[22]; float* out; unsigned char* ws; int ph_lo, ph_hi; };

__device__ __forceinline__ void p0_tr_item(const float* W, int K, int N, int k0, int n0, bf16_t* WT, int drow0, const float* gk, LAS float* scr, int lane) {
    float v_[32];
#pragma unroll
    for (int i = 0; i < 32; ++i) { const int kk = 2 * i + (lane >> 5); v_[i] = W[(size_t)(k0 + kk) * N + n0 + (lane & 31)]; }
#pragma unroll
    for (int i = 0; i < 32; ++i) { const int kk = 2 * i + (lane >> 5); float v = v_[i]; if (gk) v *= gk[k0 + kk]; scr[kk * 33 + (lane & 31)] = v; }
    asm volatile("s_waitcnt lgkmcnt(0)" ::: "memory");
    const int c = lane & 7;
#pragma unroll
    for (int j = 0; j < 4; ++j) { const int n = (lane >> 3) + 8 * j; const LAS float* s = scr + (8 * c) * 33 + n;
        u32x4 o; o.x = cvt_pk_bf16(s[0 * 33], s[1 * 33]); o.y = cvt_pk_bf16(s[2 * 33], s[3 * 33]); o.z = cvt_pk_bf16(s[4 * 33], s[5 * 33]); o.w = cvt_pk_bf16(s[6 * 33], s[7 * 33]);
        *(u32x4*)(WT + (size_t)(drow0 + n) * K + k0 + 8 * c) = o; }
    asm volatile("s_waitcnt lgkmcnt(0)" ::: "memory");
}

template <int MODE>
__device__ __forceinline__ void norm_row(const float* xrow, const float* g, const float* mod_s, const float* bada, int shoff, int scoff, void* orow, int lane) {
    const f32x4* xr = (const f32x4*)xrow + lane;
    f32x4 v[8]; float s2 = 0.f;
#pragma unroll
    for (int j = 0; j < 8; ++j) { v[j] = xr[64 * j]; s2 += (v[j].x * v[j].x + v[j].y * v[j].y) + (v[j].z * v[j].z + v[j].w * v[j].w); }
    const float rstd = 1.0f / sqrtf(wave_sum(s2) * (1.f / DM) + EPS);
#pragma unroll
    for (int j = 0; j < 8; ++j) {
        const int c = (lane + 64 * j) * 4;
        const f32x4 gg = *(const f32x4*)(g + c);
        f32x4 y = v[j] * rstd * gg;
        if (MODE == 0) {
            const f32x4 sh = *(const f32x4*)(mod_s + shoff + c) + *(const f32x4*)(bada + shoff + c);
            const f32x4 sc = *(const f32x4*)(mod_s + scoff + c) + *(const f32x4*)(bada + scoff + c);
            y = y * (sc + 1.0f) + sh;
            u32x2 w; w.x = cvt_pk_bf16(y.x, y.y); w.y = cvt_pk_bf16(y.z, y.w);
            *((u32x2*)orow + lane + 64 * j) = w;
        } else {
            *((f32x4*)orow + lane + 64 * j) = y;
        }
    }
}

__global__ void __launch_bounds__(NWAVES * 64, 2) mk_fwd(Args args) {
    extern __shared__ __attribute__((aligned(16))) unsigned char lds_raw[];
    LAS unsigned char* lds = (LAS unsigned char*)lds_raw;
    const int tid = threadIdx.x, lane = tid & 63, wave = __builtin_amdgcn_readfirstlane(tid >> 6);
    const int G = gridDim.x, bx = blockIdx.x;
    const int gw = bx * NWAVES + wave, NGW = G * NWAVES;
#define ws (args.ws)
#define xin (args.in[0])
#define cvec (args.in[1])
#define ctx (args.in[2])
#define c_ctx (args.in[3])
#define w_ada (args.in[4])
#define b_ada (args.in[5])
#define norm1_g (args.in[6])
#define norm2_g (args.in[7])
#define w_in (args.in[8])
#define da_lambda (args.in[9])
#define da_g (args.in[10])
#define mla_q_g (args.in[11])
#define mla_kv_g (args.in[12])
#define w_uq (args.in[13])
#define w_ukv (args.in[14])
#define w_o_da (args.in[15])
#define w_o_mla (args.in[16])
#define w_out (args.in[17])
#define w_gate (args.in[18])
#define w_up (args.in[19])
#define w_down (args.in[20])
#define final_g (args.in[21])
#define out (args.out)
#define mod ((float*)(ws + WS_MOD))
#define rope ((f32x2*)(ws + WS_ROPE))
#define rstd_q ((float*)(ws + WS_RSQ))
#define rstd_kv ((float*)(ws + WS_RSKV))
#define WinT ((bf16_t*)(ws + WS_WIN))
#define WuqT ((bf16_t*)(ws + WS_WUQ))
#define WukvT ((bf16_t*)(ws + WS_WUKV))
#define WodaT ((bf16_t*)(ws + WS_WODA))
#define WomlaT ((bf16_t*)(ws + WS_WOMLA))
#define WoutT ((bf16_t*)(ws + WS_WOUT))
#define WguT ((bf16_t*)(ws + WS_WGU))
#define WdT ((bf16_t*)(ws + WS_WD))
#define HB ((bf16_t*)(ws + WS_H))
#define Z ((bf16_t*)(ws + WS_Z))
#define MQ ((bf16_t*)(ws + WS_MQ))
#define KV HB
#define Y HB
#define H2 HB
#define ACT Z
#define stash ((float*)((unsigned char*)out + OUT_STASH))
#define OMLA ((bf16_t*)((unsigned char*)out + OUT_OMLA))
#define ODA ((bf16_t*)((unsigned char*)out + OUT_ODA))

    if (tid < 64) ((LAS unsigned*)(lds + LDS_MISC))[tid] = 0u;
    __syncthreads();
    XcdBarrier xbar = xcd_barrier_post((unsigned*)(ws + WS_BAR), (volatile LAS unsigned*)(lds + LDS_MISC));
    const int lo = args.ph_lo, hi = args.ph_hi;
#ifndef PH_MASK
#define PH_MASK 0xFFF
#endif
#define IN(k) (((PH_MASK >> (k)) & 1) && lo <= (k) && (k) < hi)
#ifndef PROBE_DUP
#define PROBE_DUP -1
#endif
#define REP(k) for (int rep_ = 0; rep_ < ((PROBE_DUP) == (k) ? 2 : 1); ++rep_)
#define SEAM(k) do { if (IN(k) && IN((k) + 1)) { if (lo < 0) cg::this_grid().sync(); xcd_barrier(xbar); } } while (0)

    if (IN(0)) REP(0) {
        LAS float* scr = (LAS float*)(lds + wave * 16384);
        constexpr int I_IN = 32 * 250, I_UQ = 8 * 48, I_UKV = 4 * 64, I_O = 16 * 64, I_OUT = 32 * 64, I_G = 32 * 176, I_D = 88 * 64;
        constexpr int I_PAD = 192, I_ROPE = 32, I_ADA = 32 * 48;
        constexpr int NITEMS = I_ADA + I_IN + I_UQ + I_UKV + 2 * I_O + I_OUT + 2 * I_G + I_D + I_PAD + I_ROPE;
        for (int it = gw; it < NITEMS; it += NGW) {
            int r = it;
            if (r < I_ADA) {
                const int kc = r / 48, cb = r % 48, n = cb * 256 + lane * 4;
                f32x4 a0 = {0, 0, 0, 0}, a1 = a0, a2 = a0;
#pragma unroll 8
                for (int kk = 0; kk < 64; ++kk) { const int k = kc * 64 + kk;
                    const f32x4 w = *(const f32x4*)(w_ada + (size_t)k * MODW + n);
                    const float c0 = cvec[k], c1 = cvec[DM + k], c2 = c_ctx[k];
                    a0 += w * (c0 * sigmoidf_(c0)); a1 += w * (c1 * sigmoidf_(c1)); a2 += w * (c2 * sigmoidf_(c2)); }
#pragma unroll
                for (int j = 0; j < 4; ++j) { atomicAdd(mod + n + j, a0[j]); atomicAdd(mod + MODW + n + j, a1[j]); atomicAdd(mod + 2 * MODW + n + j, a2[j]); }
                continue; } r -= I_ADA;
            if (r < I_IN) { const int kb = r / 250, nb = r % 250, n0 = nb * 32; p0_tr_item(w_in, DM, INW, kb * 64, n0, WinT, n0 + (n0 >= 3904 ? 192 : 0), nullptr, scr, lane); continue; } r -= I_IN;
            if (r < I_UQ) { const int kb = r / 48, nb = r % 48; p0_tr_item(w_uq, 512, MQW, kb * 64, nb * 32, WuqT, nb * 32, mla_q_g, scr, lane); continue; } r -= I_UQ;
            if (r < I_UKV) { const int kb = r / 64, nb = r % 64; p0_tr_item(w_ukv, 256, KVW, kb * 64, nb * 32, WukvT, nb * 32, mla_kv_g, scr, lane); continue; } r -= I_UKV;
            if (r < I_O) { const int kb = r / 64, nb = r % 64; p0_tr_item(w_o_da, OW, DM, kb * 64, nb * 32, WodaT, nb * 32, nullptr, scr, lane); continue; } r -= I_O;
            if (r < I_O) { const int kb = r / 64, nb = r % 64; p0_tr_item(w_o_mla, OW, DM, kb * 64, nb * 32, WomlaT, nb * 32, nullptr, scr, lane); continue; } r -= I_O;
            if (r < I_OUT) { const int kb = r / 64, nb = r % 64; p0_tr_item(w_out, DM, DM, kb * 64, nb * 32, WoutT, nb * 32, nullptr, scr, lane); continue; } r -= I_OUT;
            if (r < I_G) { const int kb = r / 176, nb = r % 176, n0 = nb * 32; p0_tr_item(w_gate, DM, FF, kb * 64, n0, WguT, (n0 >> 7) * 256 + (n0 & 127), nullptr, scr, lane); continue; } r -= I_G;
            if (r < I_G) { const int kb = r / 176, nb = r % 176, n0 = nb * 32; p0_tr_item(w_up, DM, FF, kb * 64, n0, WguT, (n0 >> 7) * 256 + 128 + (n0 & 127), nullptr, scr, lane); continue; } r -= I_G;
            if (r < I_D) { const int kb = r / 64, nb = r % 64; p0_tr_item(w_down, FF, DM, kb * 64, nb * 32, WdT, nb * 32, nullptr, scr, lane); continue; } r -= I_D;
            if (r < I_PAD) { u32x4* p = (u32x4*)(WinT + (size_t)(3904 + r) * DM) + lane; const u32x4 z = {0, 0, 0, 0};
#pragma unroll
                for (int j = 0; j < 4; ++j) p[64 * j] = z; continue; } r -= I_PAD;
            { const int e = r * 64 + lane, pos = e >> 4, i = e & 15;
              const float inv = exp2f(-(float)i * (13.287712379549449f / 16.0f)); const float a = (float)pos * inv;
              rope[e] = (f32x2){cosf(a), sinf(a)}; }
        }
    }
    SEAM(0);
    if (IN(1)) REP(1) {
        for (int r = gw; r < MR; r += NGW) {
            const int b = r / ROWS_B, rr = r % ROWS_B;
            const float* src = (rr < CTX) ? ctx + ((size_t)b * CTX + rr) * DM : xin + ((size_t)b * SEQ + (rr - CTX)) * DM;
            const int s = (rr < CTX) ? 2 : b;
            norm_row<0>(src, norm1_g, mod + s * MODW, b_ada, 0, DM, HB + (size_t)r * DM, lane);
        }
    }
    SEAM(1);
    if (IN(2)) REP(2) {
        { const u32x4* src = (const u32x4*)rope; LAS u32x4* dst = (LAS u32x4*)(lds + LDS_ROPE);
          dst[tid] = src[tid]; dst[tid + 512] = src[tid + 512]; __syncthreads(); }
        pg8::Gemm g{HB, WinT, DM, DM}; pg8::StaticOrder S; S.init(MR, ZW, G, bx, 0);
        pg8::EpiIn E{Z, (const LAS f32x2*)(lds + LDS_ROPE), rstd_q, rstd_kv};
        pg8::gemm_phase(lds, g, S, E);
    }
    SEAM(2);
    if (IN(4)) REP(4) {
        { const u32x4* src = (const u32x4*)rope; LAS u32x4* dst = (LAS u32x4*)(lds + LDS_ROPE);
          dst[tid] = src[tid]; dst[tid + 512] = src[tid + 512]; __syncthreads(); }
        { pg8::Gemm g{Z + Z_CQ, WuqT, ZW, 512}; pg8::StaticOrder S; S.init(ML, MQW, G, bx, 1);
          pg8::EpiMq E{MQ, (const LAS f32x2*)(lds + LDS_ROPE), rstd_q}; pg8::gemm_phase(lds, g, S, E); }
        { pg8::Gemm g{Z + Z_CKV, WukvT, ZW, 256}; pg8::StaticOrder S; S.init(MR, KVW, G, (bx + 128) % G, 0);
          pg8::EpiKv E{KV, rstd_kv}; pg8::gemm_phase(lds, g, S, E); }
    }
    SEAM(4);
    if (IN(5)) {
        const int r32 = lane & 31, hh = lane >> 5;
        float lam;
        { const float a = da_lambda[lane] * da_lambda[64 + lane], b2 = da_lambda[128 + lane] * da_lambda[192 + lane];
          lam = __expf(wave_sum(a)) - __expf(wave_sum(b2)) + LAM_INIT; }
        const int vcu = (G % 8 == 0) ? (bx & 7) * (G >> 3) + (bx >> 3) : bx;
#ifndef ATT_SKIP_DA
        for (int w = vcu; w < 256; w += G)
        for (int slot = 0; slot < 2; ++slot) REP(50) {
            const int pr = (w >> 5) * 2 + slot, qt = w & 31, b = pr >> 3, h = pr & 7;
            const int rowq = b * ROWS_B + CTX + qt * 256 + wave * 32;
            const bf16_t* Zb = Z + (size_t)b * ROWS_B * ZW;
            f32x16 o[4];
            float* st = stash + ((size_t)(bx * NWAVES + wave) * 64) * 64 + lane * 4;
            for (int sub = 0; sub < 2; ++sub) {
                const int sh_ = 2 * h + sub;
                att::attn_pass<false, ZW, ZW, ZW, ATT_TWO_DA>((LAS char*)lds, Z + (size_t)(rowq + r32) * ZW + Z_DQ + sh_ * 64 + hh * 8, nullptr,
                                      Zb + Z_DK + sh_ * 64, Zb + Z_DV + h * 128, o);
                if (sub == 0) {
                    f32x4* stp = (f32x4*)st; asm volatile("" : "+v"(stp));
#pragma unroll
                    for (int d = 0; d < 4; ++d)
#pragma unroll
                        for (int r = 0; r < 16; r += 4) stp[(d * 4 + (r >> 2)) * 64] = (f32x4){o[d][r], o[d][r + 1], o[d][r + 2], o[d][r + 3]};
                }
            }
            float ss[16];
#pragma unroll
            for (int r = 0; r < 16; ++r) ss[r] = 0.f;
#pragma unroll
            for (int d = 0; d < 4; ++d) {
                const f32x4* stp = (const f32x4*)st + d * 256; asm volatile("" : "+v"(stp));
#pragma unroll
                for (int r = 0; r < 16; r += 4) { const f32x4 sv = stp[(r >> 2) * 64];
#pragma unroll
                    for (int q = 0; q < 4; ++q) { const float v = sv[q] - lam * o[d][r + q]; o[d][r + q] = v; ss[r + q] += v * v; } } }
#pragma unroll
            for (int r = 0; r < 16; ++r) {
                float s = ss[r];
                s += __shfl_xor(s, 1); s += __shfl_xor(s, 2); s += __shfl_xor(s, 4); s += __shfl_xor(s, 8); s += __shfl_xor(s, 16);
                ss[r] = (1.0f - LAM_INIT) / sqrtf(s * (1.f / 128.f) + EPS);
            }
#pragma unroll
            for (int d = 0; d < 4; ++d) { const float gg = da_g[d * 32 + r32];
                bf16_t* zo = ODA + (size_t)(rowq + 4 * hh) * OW + h * 128 + d * 32 + r32; asm volatile("" : "+v"(zo));
#pragma unroll
                for (int r = 0; r < 16; ++r) {
                    const float v = o[d][r] * ss[r] * gg;
                    zo[(size_t)((r & 3) + 8 * (r >> 2)) * OW] = (bf16_t)(cvt_pk_bf16(v, v) & 0xffffu);
                } }
        }
#endif
#ifndef ATT_SKIP_MLA
        for (int w = vcu; w < 256; w += G)
        for (int slot = 0; slot < 2; ++slot) REP(51) {
            const int pr = (w >> 5) * 2 + slot, qt = w & 31, b = pr >> 3, h = pr & 7;
            const int rowq = b * ROWS_B + CTX + qt * 256 + wave * 32;
            const bf16_t* Zb = Z + (size_t)b * ROWS_B * ZW;
            f32x16 o[4];
            att::attn_pass<true, KVW, ZW, KVW, ATT_TWO_MLA>((LAS char*)lds, MQ + (size_t)(rowq + r32) * MQW + h * 192 + hh * 8,
                                 KV + (size_t)b * ROWS_B * KVW + h * 256, Zb + Z_KR, KV + (size_t)b * ROWS_B * KVW + h * 256 + 128, o);
#pragma unroll
            for (int d = 0; d < 4; ++d) {
                bf16_t* oo = OMLA + (size_t)(rowq + 4 * hh) * OW + h * 128 + d * 32 + r32; asm volatile("" : "+v"(oo));
#pragma unroll
                for (int r = 0; r < 16; ++r)
                    oo[(size_t)((r & 3) + 8 * (r >> 2)) * OW] = (bf16_t)(cvt_pk_bf16(o[d][r], o[d][r]) & 0xffffu); }
        }
#endif
    }
    SEAM(5);
    if (IN(6)) REP(6) {
        { pg8::Gemm g{ODA, WodaT, OW, OW}; pg8::StaticOrder S; S.init(ML, DM, G, bx, 1);
          pg8::EpiMerge<false> E{Y, Z + Z_GA}; pg8::gemm_phase(lds, g, S, E); }
        { pg8::Gemm g{OMLA, WomlaT, OW, OW}; pg8::StaticOrder S; S.init(ML, DM, G, bx, 1);
          pg8::EpiMerge<true> E{Y, Z + Z_GB}; pg8::gemm_phase(lds, g, S, E); }
    }
    SEAM(6);
    if (IN(7)) REP(7) {
        pg8::Gemm g{Y, WoutT, DM, DM}; pg8::StaticOrder S; S.init(ML, DM, G, bx, 1);
        pg8::EpiRes E{xin, out, mod, b_ada, 2 * DM}; pg8::gemm_phase(lds, g, S, E);
    }
    SEAM(7);
    if (IN(8)) REP(8) {
        for (int l = gw; l < ML; l += NGW) {
            const int b = l >> 13, r = l + 256 * (1 + b);
            norm_row<0>(out + (size_t)l * DM, norm2_g, mod + b * MODW, b_ada, 3 * DM, 4 * DM, H2 + (size_t)r * DM, lane);
        }
    }
    SEAM(8);
    if (IN(9)) REP(9) {
        pg8::Gemm g{H2, WguT, DM, DM}; pg8::StaticOrder S; S.init(ML, 2 * FF, G, bx, 1);
        pg8::EpiSwiglu E{ACT}; pg8::gemm_phase(lds, g, S, E);
    }
    SEAM(9);
    if (IN(10)) {
        pg8::Gemm g{ACT, WdT, FF, FF}; pg8::StaticOrder S; S.init(ML, DM, G, bx, 1);
        pg8::EpiRes E{out, out, mod, b_ada, 5 * DM}; pg8::gemm_phase(lds, g, S, E);
    }
    SEAM(10);
    if (IN(11)) {
        for (int l = gw; l < ML; l += NGW) norm_row<1>(out + (size_t)l * DM, final_g, nullptr, nullptr, 0, 0, out + (size_t)l * DM, lane);
    }
#if PROBE_DUP == 99
    if (lo == 0 && hi == N_PHASES_K) { for (int i = 0; i < 10; ++i) xcd_barrier(xbar); }
#endif
#undef IN
#undef SEAM
}

#undef ws
#undef xin
#undef cvec
#undef ctx
#undef c_ctx
#undef w_ada
#undef b_ada
#undef norm1_g
#undef norm2_g
#undef w_in
#undef da_lambda
#undef da_g
#undef mla_q_g
#undef mla_kv_g
#undef w_uq
#undef w_ukv
#undef w_o_da
#undef w_o_mla
#undef w_out
#undef w_gate
#undef w_up
#undef w_down
#undef final_g
#undef out
#undef mod
#undef rope
#undef rstd_q
#undef rstd_kv
#undef WinT
#undef WuqT
#undef WukvT
#undef WodaT
#undef WomlaT
#undef WoutT
#undef WguT
#undef WdT
#undef HB
#undef Z
#undef MQ
#undef KV
#undef Y
#undef H2
#undef ACT
#undef stash
#undef OMLA
#undef ODA
constexpr int N_PHASES = 12;

extern "C" void kernel_launch(void* const* d_in, const int* in_sizes, int n_in, void* d_out, int out_size, void* d_ws, size_t ws_size, hipStream_t stream) {
    static int grid = 0;
    if (grid == 0) {
        if (n_in != 22 || out_size != ML * DM || ws_size < WS_END) { fprintf(stderr, "kernel_launch: unexpected shapes (n_in %d out %d ws %zu)\n", n_in, out_size, ws_size); grid = -1; return; }
        int dev = 0, cus = 0, per_cu = 0;
        hipGetDevice(&dev); hipDeviceGetAttribute(&cus, hipDeviceAttributeMultiprocessorCount, dev);
        if (hipFuncSetAttribute((const void*)mk_fwd, hipFuncAttributeMaxDynamicSharedMemorySize, LDS_BYTES) != hipSuccess) { fprintf(stderr, "kernel_launch: hipFuncSetAttribute failed\n"); grid = -1; return; }
        if (hipOccupancyMaxActiveBlocksPerMultiprocessor(&per_cu, (const void*)mk_fwd, NWAVES * 64, LDS_BYTES) != hipSuccess || per_cu < 1) { fprintf(stderr, "kernel_launch: occupancy query says %d\n", per_cu); per_cu = 1; }
        (void)hipGetLastError();
        grid = cus;
        if (grid > 256) grid = 256;
    }
    if (grid < 0) return;
    (void)hipMemsetAsync((char*)d_ws + WS_MOD, 0, CTL_ZERO_BYTES, stream);
    Args a{};
    for (int i = 0; i < 22; ++i) a.in[i] = (const float*)d_in[i];
    a.out = (float*)d_out; a.ws = (unsigned char*)d_ws;
#if MK_PER_PHASE
    for (int p = 0; p < N_PHASES; ++p) { a.ph_lo = p; a.ph_hi = p + 1; hipLaunchKernelGGL(mk_fwd, dim3(grid), dim3(NWAVES * 64), LDS_BYTES, stream, a); }
#else
    a.ph_lo = 0; a.ph_hi = N_PHASES;
    void* kargs[] = {&a};
    hipError_t e = hipLaunchCooperativeKernel((const void*)mk_fwd, dim3(grid), dim3(NWAVES * 64), kargs, LDS_BYTES, stream);
    if (e != hipSuccess) fprintf(stderr, "cooperative launch failed: %s (grid %d)\n", hipGetErrorString(e), grid);
#endif
}
```
